# Optimizing an MI355X kernel written in HIP

```python
import jax, jax.numpy as jnp
from jax import lax
import numpy as np

D_MODEL = 1024
BATCH = 8
SEQ = 8192
DEPTH = 2

GRID_W = 64
CTX_LEN = 256
N_MOD = 9
EPS = 1e-6
ROPE_BASE = 10000.0
BLOCK = 128
NEG_INF = -1e30
D_FF = 2816

MLA_HEADS = 8
MLA_Q_RANK = 256
MLA_KV_RANK = 128
MLA_NOPE_DIM = 64
MLA_ROPE_DIM = 32
MLA_V_DIM = 64
MLA_QK_DIM = MLA_NOPE_DIM + MLA_ROPE_DIM
MLA_SCALE = MLA_QK_DIM ** -0.5

WIN_HEADS = 8
WIN_KV_HEADS = 2
WIN_GROUP = WIN_HEADS // WIN_KV_HEADS
WIN_HEAD_DIM = 64
WINDOW = 128
WIN_SCALE = WIN_HEAD_DIM ** -0.5

PAIR_KV_SIZES = (MLA_KV_RANK, MLA_ROPE_DIM, WIN_KV_HEADS * WIN_HEAD_DIM, WIN_KV_HEADS * WIN_HEAD_DIM)
PAIR_Q_SIZES = (MLA_Q_RANK, WIN_HEADS * WIN_HEAD_DIM)
PAIR_KV_COLS = sum(PAIR_KV_SIZES)
PAIR_IN = PAIR_KV_COLS + sum(PAIR_Q_SIZES)
PAIR_OUT = MLA_HEADS * MLA_V_DIM + WIN_HEADS * WIN_HEAD_DIM

GLA_HEADS = 4
GLA_DK = D_MODEL // 2
GLA_DV = D_MODEL
GLA_DK_HEAD = GLA_DK // GLA_HEADS
GLA_DV_HEAD = GLA_DV // GLA_HEADS
GLA_LOWRANK = 16
GLA_GATE_NORM = 16.0
GLA_CHUNK = 64
GLA_KV_SIZES = (GLA_DK, GLA_DV, GLA_LOWRANK, GLA_LOWRANK)
GLA_Q_SIZES = (GLA_DK, GLA_DV)
GLA_KV_COLS = sum(GLA_KV_SIZES)
GLA_IN = GLA_KV_COLS + sum(GLA_Q_SIZES)

kernel_name = "hybrid_mla_swa_gla_prefix_dit"


def rms_norm(x, g):
    xf = x.astype(jnp.float32)
    return xf * lax.rsqrt(jnp.mean(xf * xf, axis=-1, keepdims=True) + EPS) * g


def split_cols(z, sizes):
    out, start = [], 0
    for s in sizes:
        out.append(z[..., start:start + s])
        start += s
    return out


def swiglu(h, w_gu, w_down):
    gu = h @ w_gu
    return (jax.nn.silu(gu[..., :D_FF]) * gu[..., D_FF:]) @ w_down


def axial_rope_tables(rows, rot_dim):
    n_freq = rot_dim // 4
    inv = ROPE_BASE ** (-jnp.arange(n_freq, dtype=jnp.float32) / n_freq)
    t = jnp.arange(rows * GRID_W)
    row = (t // GRID_W).astype(jnp.float32)
    col = (t % GRID_W).astype(jnp.float32)
    ang = jnp.concatenate([row[:, None] * inv, col[:, None] * inv], axis=-1)
    return jnp.cos(ang), jnp.sin(ang)


def apply_rope(x, rope):
    cos, sin = rope
    cos = cos[None, :, None, :]
    sin = sin[None, :, None, :]
    x1 = x[..., 0::2]
    x2 = x[..., 1::2]
    return jnp.stack([x1 * cos - x2 * sin, x1 * sin + x2 * cos], axis=-1).reshape(x.shape)


def mla_kv(z_ckv, z_kr, p, rope):
    Bsz, T, _ = z_ckv.shape
    kv = (rms_norm(z_ckv, p["mla_g_kva"]) @ p["mla_w_ukv"]).reshape(Bsz, T, MLA_HEADS, MLA_NOPE_DIM + MLA_V_DIM)
    k_nope = rms_norm(kv[..., :MLA_NOPE_DIM], p["mla_g_kn"])
    v = kv[..., MLA_NOPE_DIM:]
    k_rope = rms_norm(z_kr, p["mla_g_kr"])[:, :, None, :]
    if rope is not None:
        k_rope = apply_rope(k_rope, rope)
    k = jnp.concatenate([k_nope, jnp.broadcast_to(k_rope, (Bsz, T, MLA_HEADS, MLA_ROPE_DIM))], axis=-1)
    return k, v


def mla_q(z_cq, p, rope):
    Bsz, T, _ = z_cq.shape
    q = (rms_norm(z_cq, p["mla_g_qa"]) @ p["mla_w_uq"]).reshape(Bsz, T, MLA_HEADS, MLA_QK_DIM)
    q_nope = rms_norm(q[..., :MLA_NOPE_DIM], p["mla_g_qn"])
    q_rope = rms_norm(q[..., MLA_NOPE_DIM:], p["mla_g_qr"])
    if rope is not None:
        q_rope = apply_rope(q_rope, rope)
    return jnp.concatenate([q_nope, q_rope], axis=-1)


def dense_block_attention(q, k, v):
    Bsz, S, H, dq = q.shape
    nb = S // BLOCK
    qb = jnp.swapaxes(q.reshape(Bsz, nb, BLOCK, H, dq), 0, 1)

    def one_block(qi):
        s = jnp.einsum("bqhd,bkhd->bhqk", qi, k).astype(jnp.float32) * MLA_SCALE
        pr = jax.nn.softmax(s, axis=-1)
        return jnp.einsum("bhqk,bkhd->bqhd", pr, v)

    o = lax.map(one_block, qb)
    return jnp.swapaxes(o, 0, 1).reshape(Bsz, S, H * v.shape[-1])


def context_attention(q, k, v):
    Bsz, T, H, _ = q.shape
    s = jnp.einsum("bqhd,bkhd->bhqk", q, k).astype(jnp.float32) * MLA_SCALE
    pr = jax.nn.softmax(s, axis=-1)
    return jnp.einsum("bhqk,bkhd->bqhd", pr, v).reshape(Bsz, T, H * v.shape[-1])


def win_kv(z_k, z_v, p, rope):
    Bsz, T, _ = z_k.shape
    k = rms_norm(z_k.reshape(Bsz, T, WIN_KV_HEADS, WIN_HEAD_DIM), p["win_g_k"])
    if rope is not None:
        k = apply_rope(k, rope)
    v = z_v.reshape(Bsz, T, WIN_KV_HEADS, WIN_HEAD_DIM)
    return k, v


def win_q(z_q, p, rope):
    Bsz, T, _ = z_q.shape
    q = rms_norm(z_q.reshape(Bsz, T, WIN_HEADS, WIN_HEAD_DIM), p["win_g_q"])
    if rope is not None:
        q = apply_rope(q, rope)
    return q.reshape(Bsz, T, WIN_KV_HEADS, WIN_GROUP, WIN_HEAD_DIM)


def window_block_attention(q, k, v, kc, vc, sink):
    Bsz, S, Hkv, G, d = q.shape
    nb = S // BLOCK
    n_ctx = kc.shape[1]
    pad = ((0, 0), (BLOCK, BLOCK), (0, 0), (0, 0))
    kp = jnp.pad(k, pad)
    vp = jnp.pad(v, pad)
    qb = jnp.swapaxes(q.reshape(Bsz, nb, BLOCK, Hkv, G, d), 0, 1)
    q_off = jnp.arange(BLOCK)
    k_off = jnp.arange(3 * BLOCK) - BLOCK
    band = jnp.abs(q_off[:, None] - k_off[None, :]) <= WINDOW
    sink_col = jnp.broadcast_to(sink.astype(jnp.float32)[None, :, :, None, None], (Bsz, Hkv, G, BLOCK, 1))

    def one_block(args):
        i, qi = args
        start = i * BLOCK
        kw = lax.dynamic_slice_in_dim(kp, start, 3 * BLOCK, axis=1)
        vw = lax.dynamic_slice_in_dim(vp, start, 3 * BLOCK, axis=1)
        k_abs = start + k_off
        valid = band & ((k_abs >= 0) & (k_abs < S))[None, :]
        s_win = jnp.einsum("bqngd,bknd->bngqk", qi, kw).astype(jnp.float32) * WIN_SCALE
        s_win = jnp.where(valid, s_win, NEG_INF)
        s_ctx = jnp.einsum("bqngd,bknd->bngqk", qi, kc).astype(jnp.float32) * WIN_SCALE
        pr = jax.nn.softmax(jnp.concatenate([s_ctx, s_win, sink_col], axis=-1), axis=-1)
        return (jnp.einsum("bngqk,bknd->bqngd", pr[..., :n_ctx], vc)
                + jnp.einsum("bngqk,bknd->bqngd", pr[..., n_ctx:n_ctx + 3 * BLOCK], vw))

    o = lax.map(one_block, (jnp.arange(nb), qb))
    return jnp.swapaxes(o, 0, 1).reshape(Bsz, S, Hkv * G * d)


def sink_context_attention(q, k, v, sink):
    Bsz, T, Hkv, G, d = q.shape
    s = jnp.einsum("bqngd,bknd->bngqk", q, k).astype(jnp.float32) * WIN_SCALE
    sink_col = jnp.broadcast_to(sink.astype(jnp.float32)[None, :, :, None, None], (Bsz, Hkv, G, T, 1))
    pr = jax.nn.softmax(jnp.concatenate([s, sink_col], axis=-1), axis=-1)
    return jnp.einsum("bngqk,bknd->bqngd", pr[..., :-1], v).reshape(Bsz, T, Hkv * G * d)


def attention_pair_mixer(h, hc, p, rope_mla, rope_win, ctx_out):
    Bsz, S, _ = h.shape
    z = h @ p["w_in"]
    ckv, kr, wk, wv, cq, wq = split_cols(z, PAIR_KV_SIZES + PAIR_Q_SIZES)
    zc = hc @ (p["w_in"] if ctx_out else p["w_in"][:, :PAIR_KV_COLS])
    ckv_c, kr_c, wk_c, wv_c = split_cols(zc, PAIR_KV_SIZES)
    k_a, v_a = mla_kv(ckv, kr, p, rope_mla)
    kc_a, vc_a = mla_kv(ckv_c, kr_c, p, None)
    o_a = dense_block_attention(mla_q(cq, p, rope_mla),
                                jnp.concatenate([kc_a, k_a], axis=1),
                                jnp.concatenate([vc_a, v_a], axis=1))
    k_b, v_b = win_kv(wk, wv, p, rope_win)
    kc_b, vc_b = win_kv(wk_c, wv_c, p, None)
    o_b = window_block_attention(win_q(wq, p, rope_win), k_b, v_b, kc_b, vc_b, p["win_sink"])
    y = jnp.concatenate([o_a, o_b], axis=-1) @ p["w_out"]
    if not ctx_out:
        return y, None
    cq_c, wq_c = split_cols(zc[..., PAIR_KV_COLS:], PAIR_Q_SIZES)
    oc_a = context_attention(mla_q(cq_c, p, None), kc_a, vc_a)
    oc_b = sink_context_attention(win_q(wq_c, p, None), kc_b, vc_b, p["win_sink"])
    yc = jnp.concatenate([oc_a, oc_b], axis=-1) @ p["w_out"]
    return y, yc


def gla_chunked(q, k, v, g, s0):
    Bsz, T, H, _ = q.shape
    dv = v.shape[-1]
    n = T // GLA_CHUNK

    def to_chunks(a):
        return a.astype(jnp.float32).reshape(Bsz, n, GLA_CHUNK, H, a.shape[-1]).transpose(1, 0, 3, 2, 4)

    qc, kc, vc = to_chunks(q), to_chunks(k), to_chunks(v)
    bc = jnp.cumsum(to_chunks(g), axis=3)
    lower = jnp.tril(jnp.ones((GLA_CHUNK, GLA_CHUNK), dtype=bool))

    def step(s, inp):
        qq, kk, vv, bb = inp
        b_end = bb[:, :, -1:, :]
        q_dec = qq * jnp.exp(bb)
        k_inv = kk * jnp.exp(-bb)
        k_end = kk * jnp.exp(b_end - bb)
        a = jnp.where(lower, jnp.einsum("bhtk,bhsk->bhts", q_dec, k_inv), 0.0)
        o = jnp.einsum("bhts,bhsv->bhtv", a, vv) + jnp.einsum("bhtk,bhkv->bhtv", q_dec, s)
        s = jnp.exp(b_end[:, :, 0, :])[..., None] * s + jnp.einsum("bhsk,bhsv->bhkv", k_end, vv)
        return s, o

    s_final, o = lax.scan(step, s0.astype(jnp.float32), (qc, kc, vc, bc))
    return o.transpose(1, 0, 3, 2, 4).reshape(Bsz, T, H, dv), s_final


def gla_final_state(k, v, g):
    G = jnp.cumsum(g.astype(jnp.float32), axis=1)
    w = jnp.exp(G[:, -1:] - G)
    return jnp.einsum("bthk,bthv->bhkv", k.astype(jnp.float32) * w, v.astype(jnp.float32))


def gla_gate(z_low, w_up, b):
    return jax.nn.log_sigmoid((z_low @ w_up + b).astype(jnp.float32)) / GLA_GATE_NORM


def gla_mixer(h, hc, p, ctx_out):
    Bsz, S, _ = h.shape

    def heads(t):
        return t.reshape(t.shape[0], t.shape[1], GLA_HEADS, -1)

    def flip(t):
        return jnp.flip(t, axis=1)

    q_scale = GLA_DK_HEAD ** -0.5
    z = h @ p["w_in"]
    k, v, lf, lb, q, g = split_cols(z, GLA_KV_SIZES + GLA_Q_SIZES)
    k, v, q = heads(k), heads(v), heads(q) * q_scale
    gf = heads(gla_gate(lf, p["w_gk_f"], p["b_gk_f"]))
    gb = heads(gla_gate(lb, p["w_gk_b"], p["b_gk_b"]))
    zc = hc @ (p["w_in"] if ctx_out else p["w_in"][:, :GLA_KV_COLS])
    kc, vc, lfc, lbc = split_cols(zc, GLA_KV_SIZES)
    kc, vc = heads(kc), heads(vc)
    gfc = heads(gla_gate(lfc, p["w_gk_f"], p["b_gk_f"]))
    gbc = heads(gla_gate(lbc, p["w_gk_b"], p["b_gk_b"]))
    yc = None
    if ctx_out:
        qc_raw, g_c = split_cols(zc[..., GLA_KV_COLS:], GLA_Q_SIZES)
        qc = heads(qc_raw) * q_scale
        zero = jnp.zeros((Bsz, GLA_HEADS, GLA_DK_HEAD, GLA_DV_HEAD), jnp.float32)
        oc_f, s_f = gla_chunked(qc, kc, vc, gfc, zero)
        oc_b, s_b = gla_chunked(flip(qc), flip(kc), flip(vc), flip(gbc), zero)
        oc = rms_norm(oc_f + flip(oc_b), p["g_norm"]) * jax.nn.silu(heads(g_c))
        yc = oc.reshape(Bsz, hc.shape[1], GLA_DV) @ p["w_out"]
    else:
        s_f = gla_final_state(kc, vc, gfc)
        s_b = gla_final_state(flip(kc), flip(vc), flip(gbc))
    o_f, _ = gla_chunked(q, k, v, gf, s_f)
    o_b, _ = gla_chunked(flip(q), flip(k), flip(v), flip(gb), s_b)
    o = rms_norm(o_f + flip(o_b), p["g_norm"]) * jax.nn.silu(heads(g))
    y = o.reshape(Bsz, S, GLA_DV) @ p["w_out"]
    return y, yc


def pre_mod(t, m, norm_g, i):
    h = rms_norm(t, norm_g[i]) * (1.0 + m[..., 3 * i + 1, :]) + m[..., 3 * i, :]
    return h, m[..., 3 * i + 2, :]


def trunk_layer(x, xc, c, c_ctx, p, layer, ropes, ctx_out):
    Bsz = x.shape[0]
    mod = (jax.nn.silu(c) @ p["w_mod"] + p["b_mod"]).reshape(Bsz, 1, N_MOD, D_MODEL)
    mod_c = (jax.nn.silu(c_ctx) @ p["w_mod"] + p["b_mod"]).reshape(1, 1, N_MOD, D_MODEL)
    ng = p["norm_g"]
    h, gt = pre_mod(x, mod, ng, 0)
    hc, gtc = pre_mod(xc, mod_c, ng, 0)
    x = x + 0.5 * gt * swiglu(h, p["ffn1_w_gu"], p["ffn1_w_down"])
    xc = xc + 0.5 * gtc * swiglu(hc, p["ffn1_w_gu"], p["ffn1_w_down"])
    h, gt = pre_mod(x, mod, ng, 1)
    hc, gtc = pre_mod(xc, mod_c, ng, 1)
    if layer % 2 == 0:
        y, yc = attention_pair_mixer(h, hc, p, ropes[0], ropes[1], ctx_out)
    else:
        y, yc = gla_mixer(h, hc, p, ctx_out)
    x = x + gt * y
    h, gt = pre_mod(x, mod, ng, 2)
    x = x + 0.5 * gt * swiglu(h, p["ffn2_w_gu"], p["ffn2_w_down"])
    if ctx_out:
        xc = xc + gtc * yc
        hc, gtc = pre_mod(xc, mod_c, ng, 2)
        xc = xc + 0.5 * gtc * swiglu(hc, p["ffn2_w_gu"], p["ffn2_w_down"])
    return x, xc


def _dense(key, fan_in, shape, gain=1.0):
    return jax.random.normal(key, shape, jnp.float32) * (gain * fan_in ** -0.5)


def _gain(key, shape):
    return 1.0 + 0.05 * jax.random.normal(key, shape, jnp.float32)


def _common_params(key, pre):
    ks = jax.random.split(key, 7)
    return {
        pre + "norm_g": _gain(ks[0], (3, D_MODEL)),
        pre + "w_mod": _dense(ks[1], D_MODEL, (D_MODEL, N_MOD * D_MODEL), 0.5),
        pre + "b_mod": 0.02 * jax.random.normal(ks[2], (N_MOD * D_MODEL,), jnp.float32),
        pre + "ffn1_w_gu": _dense(ks[3], D_MODEL, (D_MODEL, 2 * D_FF)),
        pre + "ffn1_w_down": _dense(ks[4], D_FF, (D_FF, D_MODEL)),
        pre + "ffn2_w_gu": _dense(ks[5], D_MODEL, (D_MODEL, 2 * D_FF)),
        pre + "ffn2_w_down": _dense(ks[6], D_FF, (D_FF, D_MODEL)),
    }


def _pair_params(key, pre):
    ks = jax.random.split(key, 13)
    return {
        pre + "w_in": _dense(ks[0], D_MODEL, (D_MODEL, PAIR_IN)),
        pre + "mla_g_qa": _gain(ks[1], (MLA_Q_RANK,)),
        pre + "mla_g_kva": _gain(ks[2], (MLA_KV_RANK,)),
        pre + "mla_w_uq": _dense(ks[3], MLA_Q_RANK, (MLA_Q_RANK, MLA_HEADS * MLA_QK_DIM)),
        pre + "mla_w_ukv": _dense(ks[4], MLA_KV_RANK, (MLA_KV_RANK, MLA_HEADS * (MLA_NOPE_DIM + MLA_V_DIM))),
        pre + "mla_g_qn": _gain(ks[5], (MLA_NOPE_DIM,)),
        pre + "mla_g_qr": _gain(ks[6], (MLA_ROPE_DIM,)),
        pre + "mla_g_kn": _gain(ks[7], (MLA_NOPE_DIM,)),
        pre + "mla_g_kr": _gain(ks[8], (MLA_ROPE_DIM,)),
        pre + "win_g_q": _gain(ks[9], (WIN_HEAD_DIM,)),
        pre + "win_g_k": _gain(ks[10], (WIN_HEAD_DIM,)),
        pre + "win_sink": 0.5 * jax.random.normal(ks[11], (WIN_KV_HEADS, WIN_GROUP), jnp.float32),
        pre + "w_out": _dense(ks[12], PAIR_OUT, (PAIR_OUT, D_MODEL)),
    }


def _gla_params(key, pre):
    ks = jax.random.split(key, 7)
    return {
        pre + "w_in": _dense(ks[0], D_MODEL, (D_MODEL, GLA_IN)),
        pre + "w_gk_f": _dense(ks[1], GLA_LOWRANK, (GLA_LOWRANK, GLA_DK)),
        pre + "b_gk_f": 0.1 * jax.random.normal(ks[2], (GLA_DK,), jnp.float32),
        pre + "w_gk_b": _dense(ks[3], GLA_LOWRANK, (GLA_LOWRANK, GLA_DK)),
        pre + "b_gk_b": 0.1 * jax.random.normal(ks[4], (GLA_DK,), jnp.float32),
        pre + "g_norm": _gain(ks[5], (GLA_DV_HEAD,)),
        pre + "w_out": _dense(ks[6], GLA_DV, (GLA_DV, D_MODEL)),
    }


def setup_inputs(seed: int = 0) -> dict:
    key = jax.random.key(seed)
    k_x, k_c, k_ctx, k_cc, k_0a, k_0b, k_1a, k_1b = jax.random.split(key, 8)
    out = {
        "x": jax.random.normal(k_x, (BATCH, SEQ, D_MODEL), jnp.float32),
        "c": jax.random.normal(k_c, (BATCH, D_MODEL), jnp.float32),
        "ctx": jax.random.normal(k_ctx, (BATCH, CTX_LEN, D_MODEL), jnp.float32),
        "c_ctx": jax.random.normal(k_cc, (D_MODEL,), jnp.float32),
    }
    out.update(_common_params(k_0a, "l0_"))
    out.update(_pair_params(k_0b, "l0_"))
    out.update(_common_params(k_1a, "l1_"))
    out.update(_gla_params(k_1b, "l1_"))
    return out


def reference(x, c, ctx, c_ctx,
              l0_norm_g, l0_w_mod, l0_b_mod, l0_ffn1_w_gu, l0_ffn1_w_down, l0_ffn2_w_gu, l0_ffn2_w_down,
              l0_w_in, l0_mla_g_qa, l0_mla_g_kva, l0_mla_w_uq, l0_mla_w_ukv, l0_mla_g_qn, l0_mla_g_qr,
              l0_mla_g_kn, l0_mla_g_kr, l0_win_g_q, l0_win_g_k, l0_win_sink, l0_w_out,
              l1_norm_g, l1_w_mod, l1_b_mod, l1_ffn1_w_gu, l1_ffn1_w_down, l1_ffn2_w_gu, l1_ffn2_w_down,
              l1_w_in, l1_w_gk_f, l1_b_gk_f, l1_w_gk_b, l1_b_gk_b, l1_g_norm, l1_w_out):
    out_dtype = x.dtype
    rows = x.shape[1] // GRID_W
    ropes = (axial_rope_tables(rows, MLA_ROPE_DIM), axial_rope_tables(rows, WIN_HEAD_DIM))
    layers = [
        dict(norm_g=l0_norm_g, w_mod=l0_w_mod, b_mod=l0_b_mod,
             ffn1_w_gu=l0_ffn1_w_gu, ffn1_w_down=l0_ffn1_w_down,
             ffn2_w_gu=l0_ffn2_w_gu, ffn2_w_down=l0_ffn2_w_down,
             w_in=l0_w_in, mla_g_qa=l0_mla_g_qa, mla_g_kva=l0_mla_g_kva,
             mla_w_uq=l0_mla_w_uq, mla_w_ukv=l0_mla_w_ukv,
             mla_g_qn=l0_mla_g_qn, mla_g_qr=l0_mla_g_qr, mla_g_kn=l0_mla_g_kn, mla_g_kr=l0_mla_g_kr,
             win_g_q=l0_win_g_q, win_g_k=l0_win_g_k, win_sink=l0_win_sink, w_out=l0_w_out),
        dict(norm_g=l1_norm_g, w_mod=l1_w_mod, b_mod=l1_b_mod,
             ffn1_w_gu=l1_ffn1_w_gu, ffn1_w_down=l1_ffn1_w_down,
             ffn2_w_gu=l1_ffn2_w_gu, ffn2_w_down=l1_ffn2_w_down,
             w_in=l1_w_in, w_gk_f=l1_w_gk_f, b_gk_f=l1_b_gk_f, w_gk_b=l1_w_gk_b, b_gk_b=l1_b_gk_b,
             g_norm=l1_g_norm, w_out=l1_w_out),
    ]
    xc = ctx
    for layer in range(DEPTH):
        x, xc = trunk_layer(x, xc, c, c_ctx, layers[layer], layer, ropes, layer < DEPTH - 1)
    return x.astype(out_dtype)
```

```cpp
#include <hip/hip_runtime.h>
#include <hip/hip_cooperative_groups.h>
#include <cstdio>
#include <cstdint>
namespace cg = cooperative_groups;
namespace pg8 {
#define PG8_LAS __attribute__((address_space(3)))
typedef unsigned short bf16_t;
typedef short bf16x8 __attribute__((ext_vector_type(8)));
typedef float f32x4 __attribute__((ext_vector_type(4)));
typedef unsigned u32x4 __attribute__((ext_vector_type(4)));
constexpr int BM = 256, BK = 64, HALF = 128, HTB = HALF * BK * 2  , STAGE_BYTES = 8 * HTB, NXCD = 8, WGM = 8;

__host__ __device__ __forceinline__ int lds_byte(int r, int c) { const int st = (r >> 4) * 2 + (c >> 5), rr = r & 15, cc = c & 31, ob = rr * 64 + cc * 2; return st * 1024 + (ob ^ (((ob >> 9) & 1) << 5)); }
__host__ __device__ __forceinline__ void stage_rc(int b, int& R, int& C) { const int st = b / 1024, sb = b % 1024, swz = sb ^ (((sb >> 9) & 1) << 5); R = (st >> 1) * 16 + swz / 64; C = (st & 1) * 32 + (swz % 64) / 2; }
__host__ __device__ __forceinline__ int perm32(int rho) { const int n = rho >> 4, i = rho & 15; return 8 * (i >> 2) + 4 * n + (i & 3); }

struct Unit { int pm, pn; };
struct Gemm { const bf16_t* A; const bf16_t* Bt; int M, N, K; };

struct StaticOrder {
    int nM, nN, nwg, G, c;
    __host__ __device__ void init(int M, int N, int G_, int c_) { nM = M / BM; nN = N / BM; nwg = nM * nN; G = G_; c = c_; }
    __host__ __device__ bool next(int i, Unit& u) const {
        const long L = (long)i * G + c; if (L >= nwg) return false;
        int wgid = (int)L; { const int q = nwg / NXCD, r = nwg % NXCD, xcd = wgid % NXCD, off = wgid / NXCD; wgid = (xcd < r ? xcd * (q + 1) : r * (q + 1) + (xcd - r) * q) + off; }
        const int nig = WGM * nN, gid = wgid / nig, fm = gid * WGM, gsz = (nM - fm) < WGM ? (nM - fm) : WGM;
        u.pm = fm + ((wgid % nig) % gsz); u.pn = (wgid % nig) / gsz; return true;
    }
    __device__ __forceinline__ void a_ready(const Unit&) const {}
    __device__ __forceinline__ void done(const Unit&) const {}
};

__device__ __forceinline__ unsigned f2bf_(float f) { unsigned u = __builtin_bit_cast(unsigned, f); return (u + 0x7fffu + ((u >> 16) & 1u)) >> 16; }
typedef __bf16 bf16v2_e __attribute__((ext_vector_type(2)));
typedef float f32x2_e __attribute__((ext_vector_type(2)));
__device__ __forceinline__ unsigned pk2_(float lo, float hi) { return __builtin_bit_cast(unsigned, __builtin_convertvector((f32x2_e){lo, hi}, bf16v2_e)); }
__device__ __forceinline__ float silu_(float x) { return x * __builtin_amdgcn_rcpf(1.0f + __builtin_amdgcn_exp2f(-1.4426950408889634f * x)); }
constexpr float GATE_SC = 0.0625f * 1.4426950408889634f;
__device__ __forceinline__ float logsig_(float z) { return fminf(z, 0.f) - __logf(1.0f + __expf(-fabsf(z))); }

struct EpiSwiglu {
    static constexpr bool PERM = true, AFTER_DRAIN = false;
    bf16_t* O; int ldc;
    __device__ __forceinline__ void operator()(const f32x4 (&acc)[2][2][4][2], const Unit& u, int wr, int wc, int fr, int fq) const {
        const int row0 = u.pm * BM + wr * 64 + fr, col0 = u.pn * HALF + wc * 32 + 8 * fq;
#pragma unroll
        for (int ai = 0; ai < 2; ++ai)
#pragma unroll
            for (int m = 0; m < 4; ++m) {
                bf16_t* p = O + (size_t)(row0 + ai * HALF + m * 16) * ldc + col0;
                const f32x4 g0 = acc[ai][0][m][0], g1 = acc[ai][0][m][1], u0 = acc[ai][1][m][0], u1 = acc[ai][1][m][1];
                u32x4 w;
                w.x = pk2_(silu_(g0[0]) * u0[0], silu_(g0[1]) * u0[1]); w.y = pk2_(silu_(g0[2]) * u0[2], silu_(g0[3]) * u0[3]);
                w.z = pk2_(silu_(g1[0]) * u1[0], silu_(g1[1]) * u1[1]); w.w = pk2_(silu_(g1[2]) * u1[2], silu_(g1[3]) * u1[3]);
                *(u32x4*)p = w;
            }
    }
};
struct EpiResid {
    static constexpr bool PERM = false, AFTER_DRAIN = false;
    const float* xin_l; const float* xin_c; float* xout_l; float* xout_c; const float* gate; float coef;
    __device__ __forceinline__ void operator()(const f32x4 (&acc)[2][2][4][2], const Unit& u, int wr, int wc, int fr, int fq) const {
        const int rowbase = u.pm * BM; const bool isc = rowbase >= 65536; const int b = isc ? 8 : (rowbase >> 13);
        const float* xi = isc ? xin_c : xin_l; float* xo = isc ? xout_c : xout_l;
        const int lrow0 = (isc ? rowbase - 65536 : rowbase) + wr * 64 + fr; const int col0 = u.pn * BM + wc * 32 + 4 * fq;
        const float* gp = gate + (size_t)b * 9216 + col0;
#pragma unroll
        for (int bj = 0; bj < 2; ++bj)
#pragma unroll
            for (int n = 0; n < 2; ++n) {
                const f32x4 gv = *(const f32x4*)(gp + bj * HALF + n * 16) * coef;
#pragma unroll
                for (int ai = 0; ai < 2; ++ai)
#pragma unroll
                    for (int m = 0; m < 4; ++m) {
                        const size_t off = (size_t)(lrow0 + ai * HALF + m * 16) * 1024 + col0 + bj * HALF + n * 16;
                        const f32x4 xv = *(const f32x4*)(xi + off);
                        *(f32x4*)(xo + off) = xv + gv * acc[ai][bj][m][n];
                    }
            }
    }
};
template <int MODE> struct EpiBf16P {
    static constexpr bool PERM = true, AFTER_DRAIN = false;
    bf16_t* O; int ldc; const float* bias_f; const float* bias_b; float qscale;
    __device__ __forceinline__ void operator()(const f32x4 (&acc)[2][2][4][2], const Unit& u, int wr, int wc, int fr, int fq) const {
        const int row0 = u.pm * BM + wr * 64 + fr, col0 = u.pn * BM + wc * 32 + 8 * fq;
        int mode = 0; const float* bp = bias_f;
        if (MODE == 1) { if (u.pn >= 6 && u.pn < 10) { mode = 1; bp = (u.pn < 8) ? (bias_f + (col0 - 1536)) : (bias_b + (col0 - 2048)); } else if (u.pn >= 10 && u.pn < 12) mode = 2; }
#pragma unroll
        for (int bj = 0; bj < 2; ++bj) {
            f32x4 b0 = (f32x4){0.f, 0.f, 0.f, 0.f}, b1 = b0;
            if (MODE == 1 && mode == 1) { b0 = *(const f32x4*)(bp + bj * HALF); b1 = *(const f32x4*)(bp + bj * HALF + 4); }
#pragma unroll
            for (int ai = 0; ai < 2; ++ai)
#pragma unroll
                for (int m = 0; m < 4; ++m) {
                    f32x4 v0 = acc[ai][bj][m][0], v1 = acc[ai][bj][m][1];
                    if (MODE == 1) {
                        if (mode == 1) {
                            v0 = v0 + b0; v1 = v1 + b1;
#pragma unroll
                            for (int e = 0; e < 4; ++e) { v0[e] = logsig_(v0[e]) * GATE_SC; v1[e] = logsig_(v1[e]) * GATE_SC; }
                        } else if (mode == 2) { v0 = v0 * qscale; v1 = v1 * qscale; }
                    }
                    u32x4 w; w.x = pk2_(v0[0], v0[1]); w.y = pk2_(v0[2], v0[3]); w.z = pk2_(v1[0], v1[1]); w.w = pk2_(v1[2], v1[3]);
                    *(u32x4*)(O + (size_t)(row0 + ai * HALF + m * 16) * ldc + col0 + bj * HALF) = w;
                }
        }
    }
};
template <class Epi, class Sched, bool ALIGN_EPI = false, bool SP2 = false>
__device__ __forceinline__ void gemm_phase(PG8_LAS unsigned char* lds, const Gemm g, const Sched& S, const Epi& E, int tid_in) {
    const int tid = tid_in, wid = __builtin_amdgcn_readfirstlane(tid >> 6), lane = tid & 63, wr = wid >> 2, wc = wid & 3, fr = lane & 15, fq = lane >> 4;
    const int K = g.K, nt = K / BK;
    unsigned voffA[2], voffB[2];
#pragma unroll
    for (int i = 0; i < 2; ++i) { int R, C; stage_rc(tid * 16 + i * 8192, R, C); const int Rb = Epi::PERM ? ((R & ~31) + perm32(R & 31)) : R;
        voffA[i] = (unsigned)(R * K + C) * 2u; voffB[i] = (unsigned)(Rb * K + C) * 2u; }
    const size_t kstep = (size_t)(BK * 2);
    const size_t hstep = (size_t)HALF * K * 2;
    const size_t tstep = 2 * hstep;
    const unsigned ldsw = (unsigned)wid * 1024u;
    const int aoff = lds_byte(wr * 64 + fr, fq * 8), boff = lds_byte(wc * 32 + fr, fq * 8);
#define PG8_SA(b, h) (((b) * 2 + (h)) * HTB)
#define PG8_SB(b, h) ((4 + (b) * 2 + (h)) * HTB)
#define PG8_STAGE(bufoff, gbase, voff) do { _Pragma("unroll") for (int _i = 0; _i < 2; ++_i) \
        __builtin_amdgcn_global_load_lds((const unsigned*)((const char*)(gbase) + (voff)[_i]), (PG8_LAS unsigned*)(lds + (bufoff) + ldsw + _i * 8192), 16, 0, 0); } while (0)
#define PG8_LDA(dst, b, h) do { _Pragma("unroll") for (int m = 0; m < 4; ++m) _Pragma("unroll") for (int k = 0; k < 2; ++k) dst[m][k] = *(const PG8_LAS bf16x8*)(lds + PG8_SA(b, h) + aoff + m * 2048 + k * 1024); } while (0)
#define PG8_LDB(dst, b, h) do { _Pragma("unroll") for (int n = 0; n < 2; ++n) _Pragma("unroll") for (int k = 0; k < 2; ++k) dst[n][k] = *(const PG8_LAS bf16x8*)(lds + PG8_SB(b, h) + boff + n * 2048 + k * 1024); } while (0)
#define PG8_MMA(ai, bj, At, Bt) do { __builtin_amdgcn_s_setprio(1); _Pragma("unroll") for (int m = 0; m < 4; ++m) _Pragma("unroll") for (int n = 0; n < 2; ++n) _Pragma("unroll") for (int k = 0; k < 2; ++k) \
        acc[ai][bj][m][n] = __builtin_amdgcn_mfma_f32_16x16x32_bf16(Bt[n][k], At[m][k], acc[ai][bj][m][n], 0, 0, 0); __builtin_amdgcn_s_setprio(0); } while (0)
#define PG8_WAIT_V(n) asm volatile("s_waitcnt vmcnt(" #n ")" ::: "memory")
#define PG8_WAIT_L(n) asm volatile("s_waitcnt lgkmcnt(" #n ")" ::: "memory")
#define PG8_BAR __builtin_amdgcn_s_barrier()
#define PG8_SCHED __builtin_amdgcn_sched_barrier(0)
    Unit cur, nxt; int ui = 0;
    if (!S.next(0, cur)) return;
    f32x4 acc[2][2][4][2];
#pragma unroll
    for (int a = 0; a < 2; ++a)
#pragma unroll
        for (int b = 0; b < 2; ++b)
#pragma unroll
            for (int m = 0; m < 4; ++m)
#pragma unroll
                for (int n = 0; n < 2; ++n) acc[a][b][m][n] = (f32x4){0.f, 0.f, 0.f, 0.f};
    bf16x8 At[4][2], B0[2][2], B1[2][2];
    const char* cA = (const char*)g.A + (size_t)cur.pm * tstep; const char* cB = (const char*)g.Bt + (size_t)cur.pn * tstep;
    S.a_ready(cur);
    if constexpr (SP2) {
        PG8_STAGE(PG8_SB(0, 0), cB, voffB); PG8_STAGE(PG8_SB(0, 1), cB + hstep, voffB); PG8_STAGE(PG8_SA(0, 0), cA, voffA); PG8_STAGE(PG8_SA(0, 1), cA + hstep, voffA);
        if (wr == 1) PG8_BAR;
        PG8_WAIT_V(2); PG8_BAR;
        PG8_STAGE(PG8_SB(1, 0), cB + kstep, voffB); PG8_STAGE(PG8_SA(1, 0), cA + kstep, voffA); PG8_STAGE(PG8_SB(1, 1), cB + hstep + kstep, voffB);
        PG8_WAIT_V(6); PG8_BAR;
    } else {
        PG8_STAGE(PG8_SB(0, 0), cB, voffB); PG8_STAGE(PG8_SA(0, 0), cA, voffA); PG8_STAGE(PG8_SB(0, 1), cB + hstep, voffB); PG8_STAGE(PG8_SA(0, 1), cA + hstep, voffA);
        if (wr == 1) PG8_BAR;
        PG8_WAIT_V(4); PG8_BAR;
        PG8_STAGE(PG8_SB(1, 0), cB + kstep, voffB); PG8_STAGE(PG8_SA(1, 0), cA + kstep, voffA); PG8_STAGE(PG8_SB(1, 1), cB + hstep + kstep, voffB);
        PG8_WAIT_V(6); PG8_BAR;
    }
    for (;;) {
        const bool has_next = S.next(ui + 1, nxt);
        const char* nA = has_next ? (const char*)g.A + (size_t)nxt.pm * tstep : cA; const char* nB = has_next ? (const char*)g.Bt + (size_t)nxt.pn * tstep : cB;
        for (int t = 0; t < nt; t += 2) {
            const bool last = (t == nt - 2);
            const char* a1 = cA + (size_t)(t + 1) * kstep;
            const char* a2 = last ? nA : cA + (size_t)(t + 2) * kstep; const char* b2 = last ? nB : cB + (size_t)(t + 2) * kstep;
            const char* a3 = a2 + kstep; const char* b3 = b2 + kstep;
            if (last && has_next) S.a_ready(nxt);
            if constexpr (SP2) {
            PG8_LDB(B0, 0, 0); PG8_LDB(B1, 0, 1); PG8_SCHED; PG8_LDA(At, 0, 0); PG8_STAGE(PG8_SA(1, 1), a1 + hstep, voffA);
            PG8_WAIT_V(8); PG8_WAIT_L(0); PG8_BAR; PG8_MMA(0, 0, At, B0); PG8_MMA(0, 1, At, B1); PG8_BAR; PG8_SCHED;
            PG8_LDA(At, 0, 1); PG8_STAGE(PG8_SB(0, 0), b2, voffB); PG8_STAGE(PG8_SB(0, 1), b2 + hstep, voffB); PG8_STAGE(PG8_SA(0, 0), a2, voffA);
            PG8_WAIT_V(8); PG8_WAIT_L(0); PG8_BAR; PG8_MMA(1, 0, At, B0); PG8_MMA(1, 1, At, B1); PG8_BAR; PG8_SCHED;
            PG8_LDB(B0, 1, 0); PG8_LDB(B1, 1, 1); PG8_SCHED; PG8_LDA(At, 1, 0); PG8_STAGE(PG8_SA(0, 1), a2 + hstep, voffA);
            PG8_WAIT_V(8); PG8_WAIT_L(0); PG8_BAR; PG8_MMA(0, 0, At, B0); PG8_MMA(0, 1, At, B1); PG8_BAR; PG8_SCHED;
            PG8_LDA(At, 1, 1); PG8_STAGE(PG8_SB(1, 0), b3, voffB); PG8_STAGE(PG8_SB(1, 1), b3 + hstep, voffB); PG8_STAGE(PG8_SA(1, 0), a3, voffA);
            PG8_WAIT_V(8); PG8_WAIT_L(0); PG8_BAR; PG8_MMA(1, 0, At, B0); PG8_MMA(1, 1, At, B1); PG8_BAR; PG8_SCHED;
            } else {
            PG8_LDB(B0, 0, 0); PG8_SCHED; PG8_LDA(At, 0, 0); PG8_STAGE(PG8_SA(1, 1), a1 + hstep, voffA);
            PG8_WAIT_L(8); PG8_BAR; PG8_WAIT_L(0); PG8_MMA(0, 0, At, B0); PG8_BAR; PG8_SCHED;
            PG8_LDB(B1, 0, 1); PG8_STAGE(PG8_SB(0, 0), b2, voffB);
            PG8_BAR; PG8_WAIT_L(0); PG8_MMA(0, 1, At, B1); PG8_BAR;
            PG8_LDA(At, 0, 1); PG8_STAGE(PG8_SA(0, 0), a2, voffA);
            PG8_BAR; PG8_WAIT_L(0); PG8_MMA(1, 0, At, B0); PG8_BAR; PG8_SCHED;
            PG8_STAGE(PG8_SB(0, 1), b2 + hstep, voffB);
            PG8_WAIT_V(6); PG8_BAR; PG8_MMA(1, 1, At, B1); PG8_BAR;
            PG8_LDB(B0, 1, 0); PG8_SCHED; PG8_LDA(At, 1, 0); PG8_STAGE(PG8_SA(0, 1), a2 + hstep, voffA);
            PG8_WAIT_L(8); PG8_BAR; PG8_WAIT_L(0); PG8_MMA(0, 0, At, B0); PG8_BAR; PG8_SCHED;
            PG8_LDB(B1, 1, 1); PG8_STAGE(PG8_SB(1, 0), b3, voffB);
            PG8_BAR; PG8_WAIT_L(0); PG8_MMA(0, 1, At, B1); PG8_BAR;
            PG8_LDA(At, 1, 1); PG8_STAGE(PG8_SA(1, 0), a3, voffA);
            PG8_BAR; PG8_WAIT_L(0); PG8_MMA(1, 0, At, B0); PG8_BAR; PG8_SCHED;
            PG8_STAGE(PG8_SB(1, 1), b3 + hstep, voffB);
            PG8_WAIT_V(6); PG8_BAR; PG8_MMA(1, 1, At, B1); PG8_BAR;
            }
        }
        if constexpr (ALIGN_EPI) { if (wr == 0) PG8_BAR; }
        if constexpr (!Epi::AFTER_DRAIN) { E(acc, cur, wr, wc, fr, fq); S.done(cur); }
        if (!has_next) break;
#pragma unroll
        for (int a = 0; a < 2; ++a)
#pragma unroll
            for (int b = 0; b < 2; ++b)
#pragma unroll
                for (int m = 0; m < 4; ++m)
#pragma unroll
                    for (int n = 0; n < 2; ++n) acc[a][b][m][n] = (f32x4){0.f, 0.f, 0.f, 0.f};
        cur = nxt; cA = nA; cB = nB; ++ui;
        if constexpr (ALIGN_EPI) { if (wr == 1) PG8_BAR; }
    }
    PG8_WAIT_V(0);
    if constexpr (!ALIGN_EPI) { if (wr == 0) PG8_BAR; }
    PG8_BAR;
    if constexpr (Epi::AFTER_DRAIN) { E.fused(acc, cur, wr, wc, fr, fq, lds, wid, lane); S.done(cur); }
#undef PG8_SA
#undef PG8_SB
#undef PG8_STAGE
#undef PG8_LDA
#undef PG8_LDB
#undef PG8_MMA
#undef PG8_WAIT_V
#undef PG8_WAIT_L
#undef PG8_BAR
#undef PG8_SCHED
}
}

#define LAS __attribute__((address_space(3)))
typedef unsigned short bf16;
typedef unsigned v4u __attribute__((ext_vector_type(4)));
typedef unsigned v2u __attribute__((ext_vector_type(2)));
typedef float f32x4 __attribute__((ext_vector_type(4)));
typedef float f32x16 __attribute__((ext_vector_type(16)));
typedef short bf16x8 __attribute__((ext_vector_type(8)));
typedef short s16x4 __attribute__((ext_vector_type(4)));

constexpr int NWAVES = 8, NTHR = 512;
constexpr int NLAT = 65536, NCTX = 2048, NTOK = NLAT + NCTX, DM = 1024, DFF = 2816, SEQ = 8192, CTXL = 256, NKEY = SEQ + CTXL;
constexpr int LDS_BYTES = 147456;
constexpr int ZW0 = 1280;
constexpr int UPK = 384, UPN = 1792;
constexpr int ZW1 = 4096;

constexpr size_t SZ_GU = (size_t)2 * DFF * DM * 2, SZ_DN = (size_t)DM * DFF * 2, SZ_IN0 = (size_t)ZW0 * DM * 2, SZ_UP = (size_t)UPN * UPK * 2, SZ_OUT = (size_t)DM * DM * 2, SZ_IN1 = (size_t)ZW1 * DM * 2;
constexpr size_t CTL_BYTES = 65536;
constexpr size_t O_GU0A = CTL_BYTES, O_DN0A = O_GU0A + SZ_GU, O_GU0B = O_DN0A + SZ_DN, O_DN0B = O_GU0B + SZ_GU, O_GU1A = O_DN0B + SZ_DN, O_DN1A = O_GU1A + SZ_GU, O_GU1B = O_DN1A + SZ_DN, O_DN1B = O_GU1B + SZ_GU;
constexpr size_t O_IN0 = O_DN1B + SZ_DN, O_UP = O_IN0 + SZ_IN0, O_OUT0 = O_UP + SZ_UP, O_IN1 = O_OUT0 + SZ_OUT, O_OUT1 = O_IN1 + SZ_IN1;
constexpr size_t O_MODP = O_OUT1 + SZ_OUT, SZ_MODP = (size_t)2 * 16 * 9 * 9216 * 4, O_MOD = O_MODP + SZ_MODP, SZ_MOD = (size_t)2 * 9 * 9216 * 4;
constexpr size_t O_XC = O_MOD + SZ_MOD, SZ_XC = (size_t)NCTX * DM * 4;
constexpr size_t O_H = O_XC + SZ_XC, SZ_H = (size_t)NTOK * DM * 2;
constexpr size_t O_R = O_H + SZ_H;
constexpr size_t O_HID = O_R, SZ_HID = (size_t)NTOK * DFF * 2;
constexpr size_t O_Z0 = O_R, SZ_Z0 = (size_t)NTOK * UPN * 2;
constexpr size_t O_CN = O_Z0 + SZ_Z0, SZ_CN = (size_t)NTOK * UPK * 2;
constexpr size_t O_QM = O_CN + SZ_CN, SZ_QM = (size_t)NTOK * 768 * 2;
constexpr size_t O_KM = O_QM + SZ_QM, SZ_KM = (size_t)8 * 8 * NKEY * 96 * 2;
constexpr size_t O_VM = O_KM + SZ_KM, SZ_VM = (size_t)8 * 8 * NKEY * 64 * 2;
constexpr size_t O_KW = O_VM + SZ_VM, SZ_KW = (size_t)8 * 2 * NKEY * 64 * 2;
constexpr size_t O_VW = O_KW + SZ_KW;
constexpr size_t O_QW = O_VW + SZ_KW, SZ_QW = (size_t)NTOK * 512 * 2;
constexpr size_t O_END0 = O_QW + SZ_QW;
constexpr size_t O_Z1 = O_R, SZ_Z1 = (size_t)NTOK * ZW1 * 2;
constexpr size_t O_OB = O_Z1 + SZ_Z1, SZ_OB = (size_t)NLAT * DM * 2;
constexpr size_t O_END1 = O_OB + SZ_OB;
constexpr size_t WS_NEED = (O_END1 > O_END0 ? O_END1 : O_END0) > (O_HID + SZ_HID) ? (O_END1 > O_END0 ? O_END1 : O_END0) : (O_HID + SZ_HID);
static_assert(O_R % 256 == 0 && O_CN % 256 == 0 && O_OB % 256 == 0, "alignment");

#define GAS __attribute__((address_space(1)))
#define LDS_WAIT() asm volatile("s_waitcnt lgkmcnt(0)" ::: "memory")
typedef __bf16 bf16v2_t __attribute__((ext_vector_type(2)));
typedef float f32x2_t __attribute__((ext_vector_type(2)));
__device__ __forceinline__ unsigned pk2(float lo, float hi) { return __builtin_bit_cast(unsigned, __builtin_convertvector((f32x2_t){lo, hi}, bf16v2_t)); }
__device__ __forceinline__ unsigned f2bf(float f) { return pk2(f, f) & 0xffffu; }
__device__ __forceinline__ float bf2f(unsigned short h) { return __builtin_bit_cast(float, (unsigned)h << 16); }
__device__ __forceinline__ float bflo(unsigned w) { return __builtin_bit_cast(float, w << 16); }
__device__ __forceinline__ float bfhi(unsigned w) { return __builtin_bit_cast(float, w & 0xffff0000u); }
__device__ __forceinline__ float wave_sum(float v) {
#pragma unroll
    for (int o = 1; o < 64; o <<= 1) v += __shfl_xor(v, o);
    return v;
}
__device__ __forceinline__ float silu_f(float x) { return x * __builtin_amdgcn_rcpf(1.0f + __builtin_amdgcn_exp2f(-1.4426950408889634f * x)); }

struct Args { const float* in[38]; float* out; unsigned char* ws; };

__device__ __forceinline__ void tr_item(const float* W, int ldw, int k0, int n0, bf16* WT, int ldt, int drow0, int dcol0, LAS float* scr, int lane) {
#pragma unroll 8
    for (int i = 0; i < 32; ++i) { const int kk = 2 * i + (lane >> 5); scr[kk * 33 + (lane & 31)] = W[(size_t)(k0 + kk) * ldw + n0 + (lane & 31)]; }
    LDS_WAIT(); asm volatile("" ::: "memory");
    const int c = lane & 7;
#pragma unroll
    for (int j = 0; j < 4; ++j) { const int n = (lane >> 3) + 8 * j; const LAS float* s = scr + (8 * c) * 33 + n;
        v4u o; o.x = pk2(s[0 * 33], s[1 * 33]); o.y = pk2(s[2 * 33], s[3 * 33]); o.z = pk2(s[4 * 33], s[5 * 33]); o.w = pk2(s[6 * 33], s[7 * 33]);
        *(v4u*)(WT + (size_t)(drow0 + n) * ldt + dcol0 + 8 * c) = o; }
    LDS_WAIT(); asm volatile("" ::: "memory");
}
__device__ __forceinline__ void tr_matrix(const float* W, int K, int N, bf16* WT, int mode, LAS float* scr, int lane, int gw, int NGW) {
    const int nblk = N / 32, items = (K / 64) * nblk;
    for (int it = gw; it < items; it += NGW) {
        const int kb = it / nblk, nb = it % nblk, n0 = nb * 32;
        int drow = n0;
        if (mode == 1) { const int half = n0 >= DFF ? 1 : 0, j = n0 - half * DFF; drow = (j >> 7) * 256 + half * 128 + (j & 127); }
        tr_item(W, N, kb * 64, n0, WT, K, drow, kb * 64, scr, lane);
    }
}

__device__ __forceinline__ void phase0(const Args& a, LAS unsigned char* lds, int tid, int lane, int wave, int G) {
    unsigned char* ws = a.ws;
    {
        LAS float* sl = (LAS float*)lds;
        for (int item = blockIdx.x; item < 2 * 16 * 18; item += G) {
            const int l = item / (16 * 18), kc = (item / 18) % 16, cb = item % 18;
            __syncthreads();
            for (int e = tid; e < 9 * 64; e += NTHR) { const int b = e / 64, k = e % 64; const float cv = (b < 8) ? a.in[1][b * DM + kc * 64 + k] : a.in[3][kc * 64 + k]; sl[e] = silu_f(cv); }
            __syncthreads();
            const float* wm = a.in[l == 0 ? 5 : 25] + (size_t)(kc * 64) * 9216 + cb * 512 + tid;
            float acc[9];
#pragma unroll
            for (int b = 0; b < 9; ++b) acc[b] = 0.f;
            for (int k = 0; k < 64; ++k) { const float w = wm[(size_t)k * 9216];
#pragma unroll
                for (int b = 0; b < 9; ++b) acc[b] += sl[b * 64 + k] * w; }
            float* mp = (float*)(ws + O_MODP) + ((size_t)(l * 16 + kc) * 9) * 9216 + cb * 512 + tid;
#pragma unroll
            for (int b = 0; b < 9; ++b) mp[(size_t)b * 9216] = acc[b];
        }
        __syncthreads();
    }
    LAS float* scr = (LAS float*)(lds + wave * 16384);
    const int gw = blockIdx.x * NWAVES + wave, NGW = G * NWAVES;
    tr_matrix(a.in[7], DM, 2 * DFF, (bf16*)(ws + O_GU0A), 1, scr, lane, gw, NGW);
    tr_matrix(a.in[9], DM, 2 * DFF, (bf16*)(ws + O_GU0B), 1, scr, lane, gw, NGW);
    tr_matrix(a.in[27], DM, 2 * DFF, (bf16*)(ws + O_GU1A), 1, scr, lane, gw, NGW);
    tr_matrix(a.in[29], DM, 2 * DFF, (bf16*)(ws + O_GU1B), 1, scr, lane, gw, NGW);
    tr_matrix(a.in[8], DFF, DM, (bf16*)(ws + O_DN0A), 0, scr, lane, gw, NGW);
    tr_matrix(a.in[10], DFF, DM, (bf16*)(ws + O_DN0B), 0, scr, lane, gw, NGW);
    tr_matrix(a.in[28], DFF, DM, (bf16*)(ws + O_DN1A), 0, scr, lane, gw, NGW);
    tr_matrix(a.in[30], DFF, DM, (bf16*)(ws + O_DN1B), 0, scr, lane, gw, NGW);
    tr_matrix(a.in[11], DM, 1184, (bf16*)(ws + O_IN0), 0, scr, lane, gw, NGW);
    tr_matrix(a.in[23], DM, DM, (bf16*)(ws + O_OUT0), 0, scr, lane, gw, NGW);
    tr_matrix(a.in[37], DM, DM, (bf16*)(ws + O_OUT1), 0, scr, lane, gw, NGW);
    for (int it = gw; it < 2 * 32; it += NGW) { const int kb = it / 32, nb = it % 32; tr_item(a.in[15], 1024, kb * 64, nb * 32, (bf16*)(ws + O_UP), UPK, nb * 32, kb * 64, scr, lane); }
    for (int it = gw; it < 4 * 24; it += NGW) { const int kb = it / 24, nb = it % 24; tr_item(a.in[14], 768, kb * 64, nb * 32, (bf16*)(ws + O_UP), UPK, 1024 + nb * 32, 128 + kb * 64, scr, lane); }
    for (int it = gw; it < 16 * 97; it += NGW) { const int kb = it / 97, nb = it % 97; if (nb == 48) continue;
        const int drow = nb < 48 ? nb * 32 : (nb < 65 ? 2560 + (nb - 49) * 32 : 3072 + (nb - 65) * 32);
        tr_item(a.in[31], 3104, kb * 64, nb * 32, (bf16*)(ws + O_IN1), DM, drow, kb * 64, scr, lane); }
    const int gt = blockIdx.x * NTHR + tid, NGT = G * NTHR;
    for (int it = gt; it < 1024 * 128; it += NGT) {
        const int n = it >> 7, k8 = (it & 127) * 8; const int dir = n >> 9, nn = n & 511;
        const float* wg = a.in[dir ? 34 : 32] + nn; const float* wi = a.in[31] + (size_t)k8 * 3104 + 1536 + 16 * dir;
        float wr[16];
#pragma unroll
        for (int r = 0; r < 16; ++r) wr[r] = wg[r * 512];
        float o[8];
#pragma unroll
        for (int e = 0; e < 8; ++e) { float s = 0.f;
#pragma unroll
            for (int r = 0; r < 16; ++r) s += wi[(size_t)e * 3104 + r] * wr[r];
            o[e] = s; }
        v4u w; w.x = pk2(o[0], o[1]); w.y = pk2(o[2], o[3]); w.z = pk2(o[4], o[5]); w.w = pk2(o[6], o[7]);
        *(v4u*)((bf16*)(ws + O_IN1) + (size_t)(1536 + n) * DM + k8) = w;
    }
    for (int it = gt; it < 96 * 128; it += NGT) *(v4u*)((bf16*)(ws + O_IN0) + (size_t)1184 * DM + (size_t)it * 8) = (v4u){0u, 0u, 0u, 0u};
    for (int it = gt; it < 1024 * 32; it += NGT) { const int r = it >> 5, c = it & 31; *(v4u*)((bf16*)(ws + O_UP) + (size_t)r * UPK + 128 + c * 8) = (v4u){0u, 0u, 0u, 0u}; }
    for (int it = gt; it < 768 * 16; it += NGT) { const int r = it >> 4, c = it & 15; *(v4u*)((bf16*)(ws + O_UP) + (size_t)(1024 + r) * UPK + c * 8) = (v4u){0u, 0u, 0u, 0u}; }
}
__device__ __forceinline__ void phase_modreduce(const Args& a, int tid, int G) {
    const int gt = blockIdx.x * NTHR + tid, NGT = G * NTHR;
    for (int it = gt; it < 2 * 9 * 9216; it += NGT) {
        const int l = it / (9 * 9216), r = it % (9 * 9216), n = r % 9216;
        const float* mp = (const float*)(a.ws + O_MODP) + (size_t)l * 16 * 9 * 9216 + r;
        float s = a.in[l == 0 ? 6 : 26][n];
        for (int kc = 0; kc < 16; ++kc) s += mp[(size_t)kc * 9 * 9216];
        ((float*)(a.ws + O_MOD))[it] = s;
    }
}
__device__ __forceinline__ void phase_norm(const float* __restrict__ xl, const float* __restrict__ xc, int nrows, const float* ng, const float* modl, int sub, bf16* __restrict__ H, int lane, int gw, int NGW) {
    const int per = (nrows + NGW - 1) / NGW, rb = gw * per, re = (rb + per) < nrows ? (rb + per) : nrows;
    if (rb >= re) return;
    int curb = -1; f32x4 G[4], S0[4];
#pragma unroll
    for (int j = 0; j < 4; ++j) { G[j] = (f32x4){0.f, 0.f, 0.f, 0.f}; S0[j] = G[j]; }
    f32x4 v[4], v1[4];
#define NORM_LD(dst, r_) do { const int rr_ = (r_) < re ? (r_) : re - 1; const float* src_ = rr_ >= NLAT ? xc + (size_t)(rr_ - NLAT) * DM : xl + (size_t)rr_ * DM; const f32x4* xr_ = (const f32x4*)src_ + lane; \
        _Pragma("unroll") for (int j = 0; j < 4; ++j) dst[j] = xr_[64 * j]; } while (0)
    NORM_LD(v, rb); NORM_LD(v1, rb + 1);
#pragma unroll 1
    for (int row = rb; row < re; ++row) {
        f32x4 vn[4];
        NORM_LD(vn, row + 2);
        const int b = row >= NLAT ? 8 : (row >> 13);
        if (b != curb) { curb = b;
            const f32x4* gp = (const f32x4*)ng + lane; const f32x4* sh = (const f32x4*)(modl + (size_t)b * 9216 + (3 * sub) * DM) + lane; const f32x4* sc = (const f32x4*)(modl + (size_t)b * 9216 + (3 * sub + 1) * DM) + lane;
#pragma unroll
            for (int j = 0; j < 4; ++j) { G[j] = gp[64 * j] * (1.0f + sc[64 * j]); S0[j] = sh[64 * j]; } }
        float ss = 0.f;
#pragma unroll
        for (int j = 0; j < 4; ++j) ss += (v[j].x * v[j].x + v[j].y * v[j].y) + (v[j].z * v[j].z + v[j].w * v[j].w);
        const float rstd = rsqrtf(wave_sum(ss) * (1.0f / DM) + 1e-6f);
        unsigned long long* o8 = (unsigned long long*)(H + (size_t)row * DM) + lane;
#pragma unroll
        for (int j = 0; j < 4; ++j) { const f32x4 h = v[j] * rstd * G[j] + S0[j];
            o8[64 * j] = (unsigned long long)pk2(h.x, h.y) | ((unsigned long long)pk2(h.z, h.w) << 32); }
#pragma unroll
        for (int j = 0; j < 4; ++j) { v[j] = v1[j]; v1[j] = vn[j]; }
    }
#undef NORM_LD
}
#define XB_TMO      128
#define XB_XCNT(j)  (256  + 64 * (j))
#define XB_XSUB(j)  (1280 + 64 * (j))
#define XB_XGEN(j)  (2304 + 64 * (j))
#define XB_TOP      3328
#define XB_TOPGEN   3392
#define XCD_BAR_WORDS 3456
#define XB_SPIN_CAP (1u << 18)

__device__ __forceinline__ unsigned xb_ld(unsigned* p)              { return __hip_atomic_load(p, __ATOMIC_RELAXED, __HIP_MEMORY_SCOPE_AGENT); }
__device__ __forceinline__ unsigned xb_add(unsigned* p, unsigned v) { return __hip_atomic_fetch_add(p, v, __ATOMIC_RELAXED, __HIP_MEMORY_SCOPE_AGENT); }
__device__ __forceinline__ unsigned xb_xcc_id() { return (unsigned)__builtin_amdgcn_s_getreg((3 << 11) | 20) & 0xFu; }
#define XB_SPIN(cond, bar) do { unsigned _sp = 0; while (cond) { __builtin_amdgcn_s_sleep(1); \
    if ((++_sp & 255u) == 0u) { if (xb_ld(&(bar)[XB_TMO])) break; if (_sp > XB_SPIN_CAP) { atomicAdd(&(bar)[XB_TMO], 1u); break; } } } } while (0)

struct XcdBarrier {
    unsigned* bar; unsigned x;
    volatile LAS unsigned* st;
};

__device__ __forceinline__ XcdBarrier xcd_barrier_post(unsigned* bar, volatile LAS unsigned* st) {
    XcdBarrier b; b.bar = bar; b.x = xb_xcc_id(); b.st = st;
    if (threadIdx.x == 0) (void)xb_add(&bar[XB_XCNT(b.x)], 1u);
    return b;
}
__device__ __forceinline__ void xcd_barrier_complete(unsigned* bar, unsigned x, unsigned& nloc, unsigned& nx) {
    const unsigned G = gridDim.x * gridDim.y * gridDim.z;
    unsigned sum, cnt, mine, sp = 0u;
    for (;;) {
        sum = 0u; cnt = 0u; mine = 0u;
#pragma unroll
        for (unsigned j = 0; j < 16; ++j) { const unsigned c = xb_ld(&bar[XB_XCNT(j)]); sum += c; cnt += (c > 0u) ? 1u : 0u; mine = (j == x) ? c : mine; }
        if (sum == G) break;
        __builtin_amdgcn_s_sleep(1);
        if ((++sp & 255u) == 0u) { if (xb_ld(&bar[XB_TMO])) break; if (sp > XB_SPIN_CAP) { atomicAdd(&bar[XB_TMO], 1u); break; } }
    }
    nloc = mine > 0u ? mine : 1u; nx = cnt > 0u ? cnt : 1u;
}

__device__ __forceinline__ void xcd_barrier(const XcdBarrier& b) {
    asm volatile("s_waitcnt vmcnt(0)" ::: "memory");
    __syncthreads();
    if (threadIdx.x == 0) {
        unsigned* bar = b.bar;
        __builtin_amdgcn_s_waitcnt(0);
        unsigned nloc = b.st[0], nx = b.st[1];
        if (nloc == 0u) { xcd_barrier_complete(bar, b.x, nloc, nx); b.st[0] = nloc; b.st[1] = nx; }
        const unsigned old = xb_add(&bar[XB_XSUB(b.x)], 1u);
        const unsigned gen = old / nloc;
        if (old + 1u == (gen + 1u) * nloc) {
            __builtin_amdgcn_fence(__ATOMIC_RELEASE, "agent");
            asm volatile("s_waitcnt vmcnt(0)" ::: "memory");
            const unsigned og = xb_add(&bar[XB_TOP], 1u);
            const unsigned tg = og / nx;
            if (og + 1u == (tg + 1u) * nx) xb_add(&bar[XB_TOPGEN], 1u);
            else XB_SPIN(xb_ld(&bar[XB_TOPGEN]) == tg, bar);
            __builtin_amdgcn_fence(__ATOMIC_ACQUIRE, "agent");
            xb_add(&bar[XB_XGEN(b.x)], 1u);
            asm volatile("s_waitcnt vmcnt(0)" ::: "memory");
        } else {
            XB_SPIN(xb_ld(&bar[XB_XGEN(b.x)]) == gen, bar);
            __builtin_amdgcn_fence(__ATOMIC_ACQUIRE, "agent");
            asm volatile("s_waitcnt vmcnt(0)" ::: "memory");
        }
    }
    __syncthreads();
}

#define MFMA16(a, b, c) __builtin_amdgcn_mfma_f32_16x16x32_bf16((a), (b), (c), 0, 0, 0)
constexpr int GQS = 136, GTS = 72;
__device__ __forceinline__ void gla_scan(const bf16* Z1, bf16* OF, bf16* OB, LAS unsigned char* lds, int tid, int lane, int wave, int G) {
    LAS bf16* Qd = (LAS bf16*)lds;
    LAS bf16* Ki = Qd + 64 * GQS;
    LAS bf16* KeT = Ki + 64 * GQS;
    LAS bf16* VT = KeT + 128 * GTS;
    LAS bf16* Am = VT + 64 * GTS;
    LAS bf16* ST = Am + 64 * GTS;
    LAS float* dec = (LAS float*)(ST + 64 * GQS);
    const int l15 = lane & 15, l4 = lane >> 4;
    for (int job = blockIdx.x; job < 256; job += G) {
        const int bh_ = 4 * (job & 7) + (job >> 6), sub_ = (job >> 3) & 7;
        const int b = bh_ >> 2, h = bh_ & 3, dir = sub_ >> 2, dvb = sub_ & 3;
        const int sgn = dir ? -1 : 1;
        bf16* Oout = dir ? OB : OF;
        const int dk = 16 * wave + l15, qd = l4;
        const int dke = dk & ~1; const int hsh = (dk & 1) ? 0 : 16;
#define GLA_SEL(x) __builtin_bit_cast(float, ((x) << hsh) & 0xffff0000u)
        const bf16* zk = Z1 + 128 * h + dke; const bf16* zq = Z1 + 2560 + 128 * h + dke; const bf16* zg = Z1 + (dir ? 2048 : 1536) + 128 * h + dke;
        const int tv = tid & 63, dvc = tid >> 6;
        const bf16* zv = Z1 + 512 + 256 * h + 64 * dvb + 8 * dvc;
        f32x4 sacc[4];
#pragma unroll
        for (int i = 0; i < 4; ++i) sacc[i] = (f32x4){0.f, 0.f, 0.f, 0.f};
        unsigned rg[1][16], rq[1][16], rk[1][16]; v4u rv[1];
        int r0 = NLAT + b * 256 + (dir ? 255 : 0);
#define GLA_LOAD(S, rr) do { _Pragma("unroll") for (int i = 0; i < 16; ++i) { const size_t ro = (size_t)((rr) + sgn * (16 * qd + i)) * ZW1; rg[S][i] = *(const unsigned*)(zg + ro); rq[S][i] = *(const unsigned*)(zq + ro); rk[S][i] = *(const unsigned*)(zk + ro); } \
            rv[S] = *(const v4u*)(zv + (size_t)((rr) + sgn * tv) * ZW1); } while (0)
        GLA_LOAD(0, r0);
#pragma unroll 1
        for (int c = 0; c < 132; ++c) {
          { constexpr int S = 0;
            const int rcur = r0;
            __syncthreads();
            { const int dkh = wave >> 2, dvs = wave & 3;
#pragma unroll
              for (int dkt = 0; dkt < 4; ++dkt) { v2u w; w.x = pk2(sacc[dkt][0], sacc[dkt][1]); w.y = pk2(sacc[dkt][2], sacc[dkt][3]);
                  *(LAS v2u*)(ST + (16 * dvs + l15) * GQS + 64 * dkh + 16 * dkt + 4 * l4) = w; } }
#ifdef PROBE_GLA_T2
#pragma unroll 1
            for (int rep_ = 0; rep_ < 2; ++rep_)
#endif
            {
                float p[16]; float run = 0.f;
#pragma unroll
                for (int i = 0; i < 16; ++i) { run += GLA_SEL(rg[S][i]); p[i] = run; }
                const float t0 = __shfl(run, l15), t1 = __shfl(run, l15 + 16), t2 = __shfl(run, l15 + 32), t3 = __shfl(run, l15 + 48);
                const float off = (qd > 0 ? t0 : 0.f) + (qd > 1 ? t1 : 0.f) + (qd > 2 ? t2 : 0.f), bend = (t0 + t1) + (t2 + t3);
                float ke[16]; const float eend = __builtin_amdgcn_exp2f(bend);
                const int dksw = dk ^ (16 * qd);
#pragma unroll
                for (int i = 0; i < 16; ++i) {
                    const float bb = p[i] + off, qv = GLA_SEL(rq[S][i]), kv = GLA_SEL(rk[S][i]);
                    const float ei = __builtin_amdgcn_exp2f(-bb);
                    Qd[(16 * qd + i) * GQS + dksw] = (bf16)pk2(qv * __builtin_amdgcn_exp2f(bb), 0.f);
                    Ki[(16 * qd + i) * GQS + dksw] = (bf16)pk2(kv * ei, 0.f);
                    ke[i] = kv * (eend * ei);
                }
                v4u w0, w1;
                w0.x = pk2(ke[0], ke[1]); w0.y = pk2(ke[2], ke[3]); w0.z = pk2(ke[4], ke[5]); w0.w = pk2(ke[6], ke[7]);
                w1.x = pk2(ke[8], ke[9]); w1.y = pk2(ke[10], ke[11]); w1.z = pk2(ke[12], ke[13]); w1.w = pk2(ke[14], ke[15]);
                *(LAS v4u*)(KeT + dk * GTS + 16 * qd) = w0; *(LAS v4u*)(KeT + dk * GTS + 16 * qd + 8) = w1;
                if (qd == 0) dec[dk] = eend;
                VT[(8 * dvc + 0) * GTS + tv] = (bf16)(rv[S].x & 0xffffu); VT[(8 * dvc + 1) * GTS + tv] = (bf16)(rv[S].x >> 16);
                VT[(8 * dvc + 2) * GTS + tv] = (bf16)(rv[S].y & 0xffffu); VT[(8 * dvc + 3) * GTS + tv] = (bf16)(rv[S].y >> 16);
                VT[(8 * dvc + 4) * GTS + tv] = (bf16)(rv[S].z & 0xffffu); VT[(8 * dvc + 5) * GTS + tv] = (bf16)(rv[S].z >> 16);
                VT[(8 * dvc + 6) * GTS + tv] = (bf16)(rv[S].w & 0xffffu); VT[(8 * dvc + 7) * GTS + tv] = (bf16)(rv[S].w >> 16);
            }
            if (c + 1 < 132) {
                r0 = (c + 1 < 4) ? (NLAT + b * 256 + (dir ? 255 - 64 * (c + 1) : 64 * (c + 1))) : (b * SEQ + (dir ? SEQ - 1 - 64 * (c + 1 - 4) : 64 * (c + 1 - 4)));
                GLA_LOAD(0, r0);
            }
            __syncthreads();
#ifdef PROBE_GLA_T3
#pragma unroll 1
            for (int rep_ = 0; rep_ < 2; ++rep_)
#endif
            if (c >= 4) {
#pragma unroll
                for (int q = 0; q < 2; ++q) {
                    const int tile = 2 * wave + q, ti = tile >> 2, si = tile & 3;
                    f32x4 acc = (f32x4){0.f, 0.f, 0.f, 0.f};
                    if (si <= ti) {
#pragma unroll
                        for (int ks = 0; ks < 4; ++ks) {
                            const bf16x8 A = *(const LAS bf16x8*)(Ki + (16 * si + l15) * GQS + ((32 * ks + 8 * l4) ^ (16 * si)));
                            const bf16x8 B = *(const LAS bf16x8*)(Qd + (16 * ti + l15) * GQS + ((32 * ks + 8 * l4) ^ (16 * ti)));
                            acc = MFMA16(A, B, acc);
                        }
                    }
                    const int t = 16 * ti + l15, s0 = 16 * si + 4 * l4;
                    v2u w; w.x = pk2(s0 + 0 <= t ? acc[0] : 0.f, s0 + 1 <= t ? acc[1] : 0.f); w.y = pk2(s0 + 2 <= t ? acc[2] : 0.f, s0 + 3 <= t ? acc[3] : 0.f);
                    *(LAS v2u*)(Am + t * GTS + s0) = w;
                }
            }
            __syncthreads();
#ifdef PROBE_GLA_T4
#pragma unroll 1
            for (int rep_ = 0; rep_ < 2; ++rep_)
#endif
            if (c >= 4) {
                const int tq = wave >> 2, dvs = wave & 3;
#pragma unroll
                for (int q = 0; q < 2; ++q) {
                    const int tt = 2 * tq + q;
                    f32x4 acc = (f32x4){0.f, 0.f, 0.f, 0.f};
#pragma unroll
                    for (int ks = 0; ks < 2; ++ks) {
                        const bf16x8 A = *(const LAS bf16x8*)(VT + (16 * dvs + l15) * GTS + 32 * ks + 8 * l4);
                        const bf16x8 B = *(const LAS bf16x8*)(Am + (16 * tt + l15) * GTS + 32 * ks + 8 * l4);
                        acc = MFMA16(A, B, acc);
                    }
#pragma unroll
                    for (int ks = 0; ks < 4; ++ks) {
                        const bf16x8 A = *(const LAS bf16x8*)(ST + (16 * dvs + l15) * GQS + 32 * ks + 8 * l4);
                        const bf16x8 B = *(const LAS bf16x8*)(Qd + (16 * tt + l15) * GQS + ((32 * ks + 8 * l4) ^ (16 * tt)));
                        acc = MFMA16(A, B, acc);
                    }
                    const int row = rcur + sgn * (16 * tt + l15);
                    v2u w; w.x = pk2(acc[0], acc[1]); w.y = pk2(acc[2], acc[3]);
                    *(v2u*)(Oout + (size_t)row * DM + 256 * h + 64 * dvb + 16 * dvs + 4 * l4) = w;
                }
            }
            { const int dkh = wave >> 2, dvs = wave & 3;
#pragma unroll
              for (int dkt = 0; dkt < 4; ++dkt) {
                  const int dk0 = 64 * dkh + 16 * dkt;
                  const f32x4 d4 = *(const LAS f32x4*)(dec + dk0 + 4 * l4);
                  sacc[dkt] = sacc[dkt] * d4;
#pragma unroll
                  for (int ks = 0; ks < 2; ++ks) {
                      const bf16x8 A = *(const LAS bf16x8*)(KeT + (dk0 + l15) * GTS + 32 * ks + 8 * l4);
                      const bf16x8 B = *(const LAS bf16x8*)(VT + (16 * dvs + l15) * GTS + 32 * ks + 8 * l4);
                      sacc[dkt] = MFMA16(A, B, sacc[dkt]);
                  }
              } }
          }
        }
#undef GLA_LOAD
#undef GLA_SEL
        __syncthreads();
    }
}
__device__ __forceinline__ void gla_combine(bf16* OF, const bf16* OB, const bf16* Z1, const float* gnorm, int lane, int gw, int NGW) {
    for (int row = gw; row < NLAT; row += NGW) {
        const v4u* pf = (const v4u*)(OF + (size_t)row * DM + 16 * lane); const v4u* pb = (const v4u*)(OB + (size_t)row * DM + 16 * lane);
        const v4u* pg = (const v4u*)(Z1 + (size_t)row * ZW1 + 3072 + 16 * lane);
        const v4u f0 = pf[0], f1 = pf[1], b0 = pb[0], b1 = pb[1], g0 = pg[0], g1 = pg[1];
        const unsigned fw[8] = {f0.x, f0.y, f0.z, f0.w, f1.x, f1.y, f1.z, f1.w}, bw[8] = {b0.x, b0.y, b0.z, b0.w, b1.x, b1.y, b1.z, b1.w}, gwd[8] = {g0.x, g0.y, g0.z, g0.w, g1.x, g1.y, g1.z, g1.w};
        float o[16]; float ss = 0.f;
#pragma unroll
        for (int e = 0; e < 8; ++e) { o[2 * e] = bflo(fw[e]) + bflo(bw[e]); o[2 * e + 1] = bfhi(fw[e]) + bfhi(bw[e]); ss += o[2 * e] * o[2 * e] + o[2 * e + 1] * o[2 * e + 1]; }
        ss += __shfl_xor(ss, 1); ss += __shfl_xor(ss, 2); ss += __shfl_xor(ss, 4); ss += __shfl_xor(ss, 8);
        const float rstd = rsqrtf(ss * (1.0f / 256.0f) + 1e-6f);
        const float* gn = gnorm + 16 * (lane & 15);
        unsigned ow[8];
#pragma unroll
        for (int e = 0; e < 8; ++e) { const float ga = bflo(gwd[e]), gb = bfhi(gwd[e]);
            ow[e] = pk2(o[2 * e] * rstd * gn[2 * e] * silu_f(ga), o[2 * e + 1] * rstd * gn[2 * e + 1] * silu_f(gb)); }
        v4u* po = (v4u*)(OF + (size_t)row * DM + 16 * lane);
        po[0] = (v4u){ow[0], ow[1], ow[2], ow[3]}; po[1] = (v4u){ow[4], ow[5], ow[6], ow[7]};
    }
}

#define MFMA32(a, b, c) __builtin_amdgcn_mfma_f32_32x32x16_bf16((a), (b), (c), 0, 0, 0)
constexpr float LOG2E = 1.4426950408889634f;
constexpr float QS_MLA = 0.10206207261596577f * LOG2E;
constexpr float QS_WIN = 0.125f * LOG2E;
constexpr float LOG2_ROPE = 13.287712379549449f;
constexpr float RESCALE_THR = 8.0f;

__device__ __forceinline__ void rope2(float& x1, float& x2, float ang) { const float s = __sinf(ang), c = __cosf(ang);   const float a = x1 * c - x2 * s, b = x1 * s + x2 * c; x1 = a; x2 = b; }

__device__ __forceinline__ void prep1(const Args& a, const bf16* __restrict__ Z0, bf16* __restrict__ CN, bf16* __restrict__ KM, bf16* __restrict__ KW, bf16* __restrict__ VW, bf16* __restrict__ QW, int lane, int gw, int NGW) {
    const float* g_qa = a.in[12]; const float* g_kva = a.in[13]; const float* g_kr = a.in[19]; const float* g_q = a.in[20]; const float* g_k = a.in[21];
    const float inv_kr = __builtin_amdgcn_exp2f(-(float)(lane & 7) * (LOG2_ROPE / 8.0f));
    const float inv_wk = __builtin_amdgcn_exp2f(-(float)(lane & 15) * (LOG2_ROPE / 16.0f));
    float inv_wq[4];
#pragma unroll
    for (int p = 0; p < 4; ++p) inv_wq[p] = __builtin_amdgcn_exp2f(-(float)((4 * (lane & 7) + p) & 15) * (LOG2_ROPE / 16.0f));
#pragma unroll 2
    for (int r = gw; r < NTOK; r += NGW) {
        const bool isc = r >= NLAT;
        int b, n; float prow = 0.f, pcol = 0.f;
        if (!isc) { b = r >> 13; const int t = r & (SEQ - 1); n = CTXL + t; prow = (float)(t >> 6); pcol = (float)(t & 63); } else { const int rc = r - NLAT; b = rc >> 8; n = rc & 255; }
        const bf16* zr = Z0 + (size_t)r * ZW0;
        {
            const unsigned w = *(const unsigned*)(zr + 2 * lane); float x0 = bflo(w), x1 = bfhi(w);
            const float rstd = rsqrtf(wave_sum(x0 * x0 + x1 * x1) * (1.0f / 128.0f) + 1e-6f);
            *(unsigned*)(CN + (size_t)r * UPK + 2 * lane) = pk2(x0 * rstd * g_kva[2 * lane], x1 * rstd * g_kva[2 * lane + 1]);
        }
        {
            const v2u w = *(const v2u*)(zr + 416 + 4 * lane); float x0 = bflo(w.x), x1 = bfhi(w.x), x2 = bflo(w.y), x3 = bfhi(w.y);
            const float rstd = rsqrtf(wave_sum((x0 * x0 + x1 * x1) + (x2 * x2 + x3 * x3)) * (1.0f / 256.0f) + 1e-6f);
            const f32x4 g = *(const f32x4*)(g_qa + 4 * lane);
            v2u o; o.x = pk2(x0 * rstd * g.x, x1 * rstd * g.y); o.y = pk2(x2 * rstd * g.z, x3 * rstd * g.w);
            *(v2u*)(CN + (size_t)r * UPK + 128 + 4 * lane) = o;
        }
        {
            float x0 = 0.f, x1 = 0.f;
            if (lane < 16) { const unsigned w = *(const unsigned*)(zr + 128 + 2 * lane); x0 = bflo(w); x1 = bfhi(w); }
            const float rstd = rsqrtf(wave_sum(x0 * x0 + x1 * x1) * (1.0f / 32.0f) + 1e-6f);
            if (lane < 16) {
                x0 *= rstd * g_kr[2 * lane]; x1 *= rstd * g_kr[2 * lane + 1];
                if (!isc) rope2(x0, x1, (lane < 8 ? prow : pcol) * inv_kr);
                const unsigned o = pk2(x0, x1);
#pragma unroll
                for (int h = 0; h < 8; ++h) *(unsigned*)(KM + ((size_t)(b * 8 + h) * NKEY + n) * 96 + 64 + 2 * lane) = o;
            }
        }
        {
            const int hk = lane >> 5, i = lane & 31;
            const unsigned w = *(const unsigned*)(zr + 160 + 2 * lane); float x0 = bflo(w), x1 = bfhi(w);
            float ss = x0 * x0 + x1 * x1;
            ss += __shfl_xor(ss, 1); ss += __shfl_xor(ss, 2); ss += __shfl_xor(ss, 4); ss += __shfl_xor(ss, 8); ss += __shfl_xor(ss, 16);
            const float rstd = rsqrtf(ss * (1.0f / 64.0f) + 1e-6f);
            x0 *= rstd * g_k[2 * i]; x1 *= rstd * g_k[2 * i + 1];
            if (!isc) rope2(x0, x1, (i < 16 ? prow : pcol) * inv_wk);
            const size_t ko = ((size_t)(b * 2 + hk) * NKEY + n) * 64 + 2 * i;
            *(unsigned*)(KW + ko) = pk2(x0, x1);
            *(unsigned*)(VW + ko) = *(const unsigned*)(zr + 288 + 2 * lane);
        }
        {
            const int j = lane & 7;
            const v4u w = *(const v4u*)(zr + 672 + 8 * lane);
            float x[8] = {bflo(w.x), bfhi(w.x), bflo(w.y), bfhi(w.y), bflo(w.z), bfhi(w.z), bflo(w.w), bfhi(w.w)};
            float ss = 0.f;
#pragma unroll
            for (int e = 0; e < 8; ++e) ss += x[e] * x[e];
            ss += __shfl_xor(ss, 1); ss += __shfl_xor(ss, 2); ss += __shfl_xor(ss, 4);
            const float rstd = rsqrtf(ss * (1.0f / 64.0f) + 1e-6f);
            const f32x4 g0 = *(const f32x4*)(g_q + 8 * j), g1 = *(const f32x4*)(g_q + 8 * j + 4);
            const float gg[8] = {g0.x, g0.y, g0.z, g0.w, g1.x, g1.y, g1.z, g1.w};
#pragma unroll
            for (int e = 0; e < 8; ++e) x[e] *= rstd * gg[e];
            if (!isc) {
                const float pos = (j < 4) ? prow : pcol;
#pragma unroll
                for (int p = 0; p < 4; ++p) rope2(x[2 * p], x[2 * p + 1], pos * inv_wq[p]);
            }
            v4u o; o.x = pk2(x[0] * QS_WIN, x[1] * QS_WIN); o.y = pk2(x[2] * QS_WIN, x[3] * QS_WIN); o.z = pk2(x[4] * QS_WIN, x[5] * QS_WIN); o.w = pk2(x[6] * QS_WIN, x[7] * QS_WIN);
            *(v4u*)(QW + (size_t)r * 512 + 8 * lane) = o;
        }
    }
}
__device__ __forceinline__ void prep2(const Args& a, const bf16* __restrict__ KVQ, bf16* __restrict__ KM, bf16* __restrict__ VM, bf16* __restrict__ QM, int lane, int gw, int NGW) {
    const float* g_qn = a.in[16]; const float* g_qr = a.in[17]; const float* g_kn = a.in[18];
    const int hh = lane >> 3, j = lane & 7;
    float inv_qr[2];
#pragma unroll
    for (int p = 0; p < 2; ++p) inv_qr[p] = __builtin_amdgcn_exp2f(-(float)((2 * j + p) & 7) * (LOG2_ROPE / 8.0f));
#pragma unroll 2
    for (int r = gw; r < NTOK; r += NGW) {
        const bool isc = r >= NLAT;
        int b, n; float prow = 0.f, pcol = 0.f;
        if (!isc) { b = r >> 13; const int t = r & (SEQ - 1); n = CTXL + t; prow = (float)(t >> 6); pcol = (float)(t & 63); } else { const int rc = r - NLAT; b = rc >> 8; n = rc & 255; }
        const bf16* kr = KVQ + (size_t)r * UPN;
        {
            const v4u w0 = *(const v4u*)(kr + 16 * lane), w1 = *(const v4u*)(kr + 16 * lane + 8);
            const unsigned ww[8] = {w0.x, w0.y, w0.z, w0.w, w1.x, w1.y, w1.z, w1.w};
            float ss = 0.f;
#pragma unroll
            for (int e = 0; e < 8; ++e) { const float p0 = bflo(ww[e]), p1 = bfhi(ww[e]); ss += p0 * p0 + p1 * p1; }
            ss += __shfl_xor(ss, 1); ss += __shfl_xor(ss, 2);
            if (j < 4) {
                const float rstd = rsqrtf(ss * (1.0f / 64.0f) + 1e-6f);
                const float* gp = g_kn + 16 * j; unsigned o[8];
#pragma unroll
                for (int e = 0; e < 8; ++e) o[e] = pk2(bflo(ww[e]) * rstd * gp[2 * e], bfhi(ww[e]) * rstd * gp[2 * e + 1]);
                bf16* dst = KM + ((size_t)(b * 8 + hh) * NKEY + n) * 96 + 16 * j;
                *(v4u*)dst = (v4u){o[0], o[1], o[2], o[3]}; *(v4u*)(dst + 8) = (v4u){o[4], o[5], o[6], o[7]};
            } else {
                bf16* dst = VM + ((size_t)(b * 8 + hh) * NKEY + n) * 64 + 16 * (j - 4);
                *(v4u*)dst = w0; *(v4u*)(dst + 8) = w1;
            }
        }
        {
            const v4u w = *(const v4u*)(kr + 1024 + 96 * hh + 8 * j);
            float x[8] = {bflo(w.x), bfhi(w.x), bflo(w.y), bfhi(w.y), bflo(w.z), bfhi(w.z), bflo(w.w), bfhi(w.w)};
            float ss = 0.f;
#pragma unroll
            for (int e = 0; e < 8; ++e) ss += x[e] * x[e];
            ss += __shfl_xor(ss, 1); ss += __shfl_xor(ss, 2); ss += __shfl_xor(ss, 4);
            const float rstd = rsqrtf(ss * (1.0f / 64.0f) + 1e-6f) * QS_MLA;
            const f32x4 g0 = *(const f32x4*)(g_qn + 8 * j), g1 = *(const f32x4*)(g_qn + 8 * j + 4);
            v4u o; o.x = pk2(x[0] * rstd * g0.x, x[1] * rstd * g0.y); o.y = pk2(x[2] * rstd * g0.z, x[3] * rstd * g0.w);
            o.z = pk2(x[4] * rstd * g1.x, x[5] * rstd * g1.y); o.w = pk2(x[6] * rstd * g1.z, x[7] * rstd * g1.w);
            *(v4u*)(QM + (size_t)r * 768 + 96 * hh + 8 * j) = o;
        }
        {
            const v2u w = *(const v2u*)(kr + 1024 + 96 * hh + 64 + 4 * j);
            float x0 = bflo(w.x), x1 = bfhi(w.x), x2 = bflo(w.y), x3 = bfhi(w.y);
            float ss = (x0 * x0 + x1 * x1) + (x2 * x2 + x3 * x3);
            ss += __shfl_xor(ss, 1); ss += __shfl_xor(ss, 2); ss += __shfl_xor(ss, 4);
            const float rstd = rsqrtf(ss * (1.0f / 32.0f) + 1e-6f);
            const f32x4 g = *(const f32x4*)(g_qr + 4 * j);
            x0 *= rstd * g.x; x1 *= rstd * g.y; x2 *= rstd * g.z; x3 *= rstd * g.w;
            if (!isc) { const float pos = (j < 4) ? prow : pcol; rope2(x0, x1, pos * inv_qr[0]); rope2(x2, x3, pos * inv_qr[1]); }
            v2u o; o.x = pk2(x0 * QS_MLA, x1 * QS_MLA); o.y = pk2(x2 * QS_MLA, x3 * QS_MLA);
            *(v2u*)(QM + (size_t)r * 768 + 96 * hh + 64 + 4 * j) = o;
        }
    }
}

typedef float f32x2 __attribute__((ext_vector_type(2)));
__device__ __forceinline__ float max3f(float a, float b, float c) { float r; asm("v_max3_f32 %0, %1, %2, %3" : "=v"(r) : "v"(a), "v"(b), "v"(c)); return r; }
template <int DQK, bool WIN>
__device__ __forceinline__ void attn_unit(const bf16* Qp, int qld, const bf16* Kb, const bf16* Vb, bf16* Op, int ntiles, int latj0, int qlat0, float m_init, float l_init,
                                          LAS unsigned char* lds, int tid, int lane, int wave) {
    constexpr int KS = DQK + 8, VS = 68, KCH = DQK / 8;
    constexpr int KBYTES = 64 * KS * 2, VBYTES = 64 * VS * 2;
    const int l31 = lane & 31, hh = lane >> 5;
    bf16x8 qf[DQK / 16];
    { const bf16* qr = Qp + (size_t)(32 * wave + l31) * qld + 8 * hh;
#pragma unroll
      for (int ks = 0; ks < DQK / 16; ++ks) qf[ks] = *(const bf16x8*)(qr + 16 * ks); }
    f32x16 ot[2];
#pragma unroll
    for (int i = 0; i < 16; ++i) { ot[0][i] = 0.f; ot[1][i] = 0.f; }
    float m = m_init, l = l_init;
    const int kc0 = tid, kc1 = tid + 512;
    const int vkey = tid & 63, vdc = tid >> 6;
    const bool has1 = (KCH * 64 > 512) && (kc1 < KCH * 64);
    const int kg0 = (kc0 / KCH) * DQK + 8 * (kc0 % KCH), kg1 = (kc1 / KCH) * DQK + 8 * (kc1 % KCH), vg = vkey * 64 + 8 * vdc;
    const int kl0 = (kc0 / KCH) * KS + 8 * (kc0 % KCH), kl1 = (kc1 / KCH) * KS + 8 * (kc1 % KCH), vl = (8 * vdc) * VS + vkey;
    v4u kA[4], kB[4], vR[4];
#pragma unroll
    for (int i = 0; i < 4; ++i) { kA[i] = (v4u){0u, 0u, 0u, 0u}; kB[i] = kA[i]; vR[i] = kA[i]; }
#define ATT_LOAD(jj, S) do { int j_ = (jj); j_ = j_ < ntiles ? j_ : ntiles - 1; const int n0_ = j_ < 4 ? 64 * j_ : CTXL + 64 * (latj0 + j_ - 4); \
        kA[S] = *(const v4u*)(Kb + (size_t)n0_ * DQK + kg0); if (has1) kB[S] = *(const v4u*)(Kb + (size_t)n0_ * DQK + kg1); vR[S] = *(const v4u*)(Vb + (size_t)n0_ * 64 + vg); } while (0)
#define ATT_STORE(kb, vb, S) do { LAS bf16* B_ = (LAS bf16*)(lds + (kb) * KBYTES); *(LAS v4u*)(B_ + kl0) = kA[S]; if (has1) *(LAS v4u*)(B_ + kl1) = kB[S]; \
        LAS bf16* vp_ = (LAS bf16*)(lds + 4 * KBYTES + (vb) * VBYTES) + vl; const v4u vr = vR[S]; \
        vp_[0 * VS] = (bf16)(vr.x & 0xffffu); vp_[1 * VS] = (bf16)(vr.x >> 16); vp_[2 * VS] = (bf16)(vr.y & 0xffffu); vp_[3 * VS] = (bf16)(vr.y >> 16); \
        vp_[4 * VS] = (bf16)(vr.z & 0xffffu); vp_[5 * VS] = (bf16)(vr.z >> 16); vp_[6 * VS] = (bf16)(vr.w & 0xffffu); vp_[7 * VS] = (bf16)(vr.w >> 16); } while (0)
#define ATT_QK(ST, kb, cc) do { const LAS bf16* Kl_ = (const LAS bf16*)(lds + (kb) * KBYTES); const float ni_ = -(cc); \
        _Pragma("unroll") for (int kt = 0; kt < 2; ++kt) { \
            _Pragma("unroll") for (int i = 0; i < 16; ++i) ST[kt][i] = ni_; \
            _Pragma("unroll") for (int ks = 0; ks < DQK / 16; ++ks) { \
                const bf16x8 A = *(const LAS bf16x8*)(Kl_ + (32 * kt + l31) * KS + 16 * ks + 8 * hh); \
                ST[kt] = MFMA32(A, qf[ks], ST[kt]); } } } while (0)
#define ATT_DECIDE(ST, cc, mxv) do { \
        if (__any((mxv) + (cc) > m + RESCALE_THR)) { \
            const float mr_ = fmaxf((mxv), __shfl_xor((mxv), 32)); \
            const float mn = fmaxf(m, mr_ + (cc)), alpha = __builtin_amdgcn_exp2f(m - mn); \
            m = mn; l *= alpha; \
            const f32x2 a2 = {alpha, alpha}; \
            _Pragma("unroll") for (int dt = 0; dt < 2; ++dt) \
                _Pragma("unroll") for (int i = 0; i < 8; ++i) { f32x2 v = {ot[dt][2 * i], ot[dt][2 * i + 1]}; v = v * a2; ot[dt][2 * i] = v.x; ot[dt][2 * i + 1] = v.y; } \
            const float dlt = (cc) - m; const f32x2 d2 = {dlt, dlt}; \
            _Pragma("unroll") for (int kt = 0; kt < 2; ++kt) \
                _Pragma("unroll") for (int i = 0; i < 8; ++i) { f32x2 v = {ST[kt][2 * i], ST[kt][2 * i + 1]}; v = v + d2; ST[kt][2 * i] = v.x; ST[kt][2 * i + 1] = v.y; } \
            cref = m; _Pragma("unroll") for (int i = 0; i < 16; ++i) negc[i] = -m; } } while (0)
#define ATT_ITER(j, S2, CUR, NXT, BAR) do { \
        ATT_STORE(((j) + 3) & 3, vst, S2); ATT_LOAD((j) + 7, S2); \
        const float c_next = cref;     \
        f32x2 ls2 = {0.f, 0.f}; \
        unsigned pw[2][8]; \
        float mxn; \
        { constexpr int KST = DQK / 16, NS = 2 * KST; \
          const LAS bf16* Kl_ = (const LAS bf16*)(lds + (((j) + 1) & 3) * KBYTES) + l31 * KS + 8 * hh; \
          const LAS bf16* Vt_ = (const LAS bf16*)(lds + 4 * KBYTES + vrd * VBYTES) + l31 * VS + 4 * hh; \
          bf16x8 kf[NS]; s16x4 vlo[8], vhi[8]; \
          kf[0] = *(const LAS bf16x8*)(Kl_); kf[1] = *(const LAS bf16x8*)(Kl_ + 16); \
          __builtin_amdgcn_sched_barrier(0); \
          _Pragma("unroll") for (int s_ = 0; s_ < NS; ++s_) { \
              if (s_ + 2 < NS) { const int kt2 = (s_ + 2) / KST, ks2 = (s_ + 2) % KST; kf[s_ + 2] = *(const LAS bf16x8*)(Kl_ + 32 * kt2 * KS + 16 * ks2); } \
              if (s_ + 2 >= NS) { const int e = s_ + 2 - NS; vlo[e] = *(const LAS s16x4*)(Vt_ + 32 * (e & 1) * VS + 32 * (e >> 2) + 16 * ((e >> 1) & 1)); vhi[e] = *(const LAS s16x4*)(Vt_ + 32 * (e & 1) * VS + 32 * (e >> 2) + 16 * ((e >> 1) & 1) + 8); } \
              { const int kt = s_ / KST, ks = s_ % KST; NXT[kt] = (ks == 0) ? MFMA32(kf[s_], qf[ks], negc) : MFMA32(kf[s_], qf[ks], NXT[kt]); } \
              { const int np = (NS == 8 || s_ < 4) ? 2 : 1, first = (NS == 8 || s_ < 4) ? 2 * s_ : s_ + 4; \
                _Pragma("unroll") for (int q_ = 0; q_ < np; ++q_) { const int pi = first + q_, kt = pi >> 3, i = pi & 7; \
                    f32x2 p; p.x = __builtin_amdgcn_exp2f(CUR[kt][2 * i]); p.y = __builtin_amdgcn_exp2f(CUR[kt][2 * i + 1]); ls2 = ls2 + p; pw[kt][i] = pk2(p.x, p.y); } } \
              __builtin_amdgcn_sched_barrier(0); \
          } \
          const int qq_ = qlat0 + 32 * wave + l31, kbase_ = 64 * (latj0 + (j) + 1 - 4) + 4 * hh; \
          mxn = -3.0e38f; \
          __builtin_amdgcn_s_setprio(1);     \
          _Pragma("unroll") for (int e = 0; e < 8; ++e) { \
              if (e + 2 < 8) { const int e2 = e + 2; vlo[e2] = *(const LAS s16x4*)(Vt_ + 32 * (e2 & 1) * VS + 32 * (e2 >> 2) + 16 * ((e2 >> 1) & 1)); vhi[e2] = *(const LAS s16x4*)(Vt_ + 32 * (e2 & 1) * VS + 32 * (e2 >> 2) + 16 * ((e2 >> 1) & 1) + 8); } \
              const int kt = e >> 2, sI = (e >> 1) & 1, dt = e & 1; \
              const v4u pv = {pw[kt][4 * sI], pw[kt][4 * sI + 1], pw[kt][4 * sI + 2], pw[kt][4 * sI + 3]}; \
              const bf16x8 pb = __builtin_bit_cast(bf16x8, pv); \
              const bf16x8 A = __builtin_shufflevector(vlo[e], vhi[e], 0, 1, 2, 3, 4, 5, 6, 7); \
              ot[dt] = MFMA32(A, pb, ot[dt]); \
              { const int kn = e >> 2, i0 = 4 * (e & 3);     \
                if (WIN && (j) + 1 >= 4) { \
                    _Pragma("unroll") for (int i = i0; i < i0 + 4; ++i) { const int kk = kbase_ + 32 * kn + (i & 3) + 8 * (i >> 2); const int d = qq_ - kk; if (d > 128 || d < -128) NXT[kn][i] = -1e30f; } } \
                mxn = max3f(mxn, NXT[kn][i0], NXT[kn][i0 + 1]); mxn = max3f(mxn, NXT[kn][i0 + 2], NXT[kn][i0 + 3]); } \
              __builtin_amdgcn_sched_barrier(0); \
          } \
          __builtin_amdgcn_s_setprio(0); } \
        l += ls2.x + ls2.y;     \
        ATT_DECIDE(NXT, c_next, mxn); \
        vrd = vrd == 4 ? 0 : vrd + 1; vst = vst == 4 ? 0 : vst + 1; \
        if (BAR) __syncthreads(); } while (0)
    ATT_LOAD(0, 0); ATT_LOAD(1, 1); ATT_LOAD(2, 2); ATT_LOAD(3, 3);
    ATT_STORE(0, 0, 0); ATT_STORE(1, 1, 1); ATT_STORE(2, 2, 2);
    ATT_LOAD(4, 0); ATT_LOAD(5, 1); ATT_LOAD(6, 2);
    __syncthreads();
    const float c0_ = m < -1e29f ? 0.f : m;
    float cref = c0_; f32x16 negc;
#pragma unroll
    for (int i = 0; i < 16; ++i) negc[i] = -c0_;
    int vrd = 0, vst = 3;
    f32x16 stA[2], stB[2];
    ATT_QK(stA, 0, c0_);
    { float mx0 = max3f(stA[0][0], stA[0][1], stA[1][0]);
#pragma unroll
      for (int i = 1; i < 8; ++i) mx0 = max3f(mx0, stA[0][2 * i], stA[0][2 * i + 1]);
#pragma unroll
      for (int i = 1; i < 8; ++i) mx0 = max3f(mx0, stA[1][2 * i], stA[1][2 * i + 1]);
      mx0 = fmaxf(mx0, stA[1][1]);
      ATT_DECIDE(stA, c0_, mx0); }
    __syncthreads();
#pragma unroll 1
    for (int j = 0; j < ntiles; j += 4) {
        ATT_ITER(j, 3, stA, stB, false);
        if (j + 1 < ntiles) ATT_ITER(j + 1, 0, stB, stA, true);
        if (j + 2 < ntiles) ATT_ITER(j + 2, 1, stA, stB, false);
        if (j + 3 < ntiles) ATT_ITER(j + 3, 2, stB, stA, true);
    }
#undef ATT_ITER
#undef ATT_DECIDE
#undef ATT_QK
#undef ATT_LOAD
#undef ATT_STORE
    l += __shfl_xor(l, 32);
    const float rl = 1.0f / l;
    bf16* orow = Op + (size_t)(32 * wave + l31) * DM + 4 * hh;
#pragma unroll
    for (int dt = 0; dt < 2; ++dt)
#pragma unroll
        for (int g = 0; g < 4; ++g) { v2u w; w.x = pk2(ot[dt][4 * g] * rl, ot[dt][4 * g + 1] * rl); w.y = pk2(ot[dt][4 * g + 2] * rl, ot[dt][4 * g + 3] * rl);
            *(v2u*)(orow + 32 * dt + 8 * g) = w; }
}

__device__ __forceinline__ void attn_phase(const Args& a, const bf16* QM, const bf16* KM, const bf16* VM, const bf16* QW, const bf16* KW, const bf16* VW, bf16* O,
                                           LAS unsigned char* lds, int tid, int lane_unused, int wave_unused, int G) {
    const float* sink = a.in[22];
    const int tid0_ = tid;
    for (int u = blockIdx.x; u < 4224; u += G) {
        int tid = tid0_; asm volatile("" : "+v"(tid));
        const int lane = tid & 63; const int wave = __builtin_amdgcn_readfirstlane(tid >> 6);
        if (u < 4096) {
            const int v = u & 2047; const int bh = (v & 7) + 8 * (v >> 8), qb = (v >> 3) & 31; const int b = bh >> 3, h = bh & 7;
            const int row0 = b * SEQ + 256 * qb;
            if (u < 2048) {
                attn_unit<96, false>(QM + (size_t)row0 * 768 + 96 * h, 768, KM + (size_t)bh * NKEY * 96, VM + (size_t)bh * NKEY * 64, O + (size_t)row0 * DM + 64 * h,
                                     132, 0, 0, -1e30f, 0.f, lds, tid, lane, wave);
            } else {
                const int hk = h >> 2; const int j0 = (4 * qb - 2) > 0 ? (4 * qb - 2) : 0, j1 = (4 * qb + 5) < 127 ? (4 * qb + 5) : 127;
                attn_unit<64, true>(QW + (size_t)row0 * 512 + 64 * h, 512, KW + (size_t)(b * 2 + hk) * NKEY * 64, VW + (size_t)(b * 2 + hk) * NKEY * 64, O + (size_t)row0 * DM + 512 + 64 * h,
                                    4 + (j1 - j0 + 1), j0, 256 * qb, sink[h] * LOG2E, 1.f, lds, tid, lane, wave);
            }
        } else {
            const int v = (u - 4096) & 63; const int b = v >> 3, h = v & 7; const int row0 = NLAT + b * CTXL;
            if (u < 4160) {
                attn_unit<96, false>(QM + (size_t)row0 * 768 + 96 * h, 768, KM + (size_t)(b * 8 + h) * NKEY * 96, VM + (size_t)(b * 8 + h) * NKEY * 64, O + (size_t)row0 * DM + 64 * h,
                                     4, 0, 0, -1e30f, 0.f, lds, tid, lane, wave);
            } else {
                const int hk = h >> 2;
                attn_unit<64, true>(QW + (size_t)row0 * 512 + 64 * h, 512, KW + (size_t)(b * 2 + hk) * NKEY * 64, VW + (size_t)(b * 2 + hk) * NKEY * 64, O + (size_t)row0 * DM + 512 + 64 * h,
                                     4, 0, 0, sink[h] * LOG2E, 1.f, lds, tid, lane, wave);
            }
        }
        __syncthreads();
    }
}
#define MIXER_L1 \
    if (l == 1) { \
        bf16* Z1 = (bf16*)(ws + O_Z1); bf16* OB = (bf16*)(ws + O_OB); \
        PH_BEGIN phase_norm(XL, XC, NTOK, ng + DM, modl, 1, H, lane, gw, NGW); PH_END \
        PROBE_ELT_X(PH_BEGIN phase_norm(XL, XC, NTOK, ng + DM, modl, 1, H, lane, gw, NGW); PH_END) \
        GEMM_PH(pg8::EpiBf16P<1>, H, (const bf16*)(ws + O_IN1), NTOK, ZW1, DM, Z1, ZW1, a.in[33], a.in[35], 0.08838834764831845f) \
        PH_BEGIN gla_scan(Z1, H, OB, lds, tid, lane, wave, G); PH_END \
        PROBE_GLA_X(PH_BEGIN gla_scan(Z1, H, OB, lds, tid, lane, wave, G); PH_END) \
        PH_BEGIN gla_combine(H, OB, Z1, a.in[36], lane, gw, NGW); PH_END \
        GEMM_PH(pg8::EpiResid, H, (const bf16*)(ws + O_OUT1), NLAT, DM, DM, XL, XC, XL, XC, modl + 5 * DM, 1.0f) \
    }
#define MIXER_L0 \
    if (l == 0) { \
        bf16* Z0 = (bf16*)(ws + O_Z0); bf16* CN = (bf16*)(ws + O_CN); bf16* QM = (bf16*)(ws + O_QM); bf16* KM = (bf16*)(ws + O_KM); bf16* VM = (bf16*)(ws + O_VM); \
        bf16* KW = (bf16*)(ws + O_KW); bf16* VW = (bf16*)(ws + O_VW); bf16* QW = (bf16*)(ws + O_QW); \
        PH_BEGIN phase_norm(XL, XC, NTOK, ng + DM, modl, 1, H, lane, gw, NGW); PH_END \
        PROBE_ELT_X(PH_BEGIN phase_norm(XL, XC, NTOK, ng + DM, modl, 1, H, lane, gw, NGW); PH_END) \
        GEMM_PH(pg8::EpiBf16P<0>, H, (const bf16*)(ws + O_IN0), NTOK, ZW0, DM, Z0, ZW0, nullptr, nullptr, 1.0f) \
        PH_BEGIN prep1(a, Z0, CN, KM, KW, VW, QW, lane, gw, NGW); PH_END \
        PROBE_ELT_X(PH_BEGIN prep1(a, Z0, CN, KM, KW, VW, QW, lane, gw, NGW); PH_END) \
        GEMM_PH(pg8::EpiBf16P<0>, CN, (const bf16*)(ws + O_UP), NTOK, UPN, UPK, Z0, UPN, nullptr, nullptr, 1.0f) \
        PH_BEGIN prep2(a, Z0, KM, VM, QM, lane, gw, NGW); PH_END \
        PROBE_ELT_X(PH_BEGIN prep2(a, Z0, KM, VM, QM, lane, gw, NGW); PH_END) \
        PH_BEGIN attn_phase(a, QM, KM, VM, QW, KW, VW, H, lds, tid, lane, wave, G); PH_END \
        PROBE_ATT_X(PH_BEGIN attn_phase(a, QM, KM, VM, QW, KW, VW, H, lds, tid, lane, wave, G); PH_END) \
        GEMM_PH(pg8::EpiResid, H, (const bf16*)(ws + O_OUT0), NTOK, DM, DM, XL, XC, XL, XC, modl + 5 * DM, 1.0f) \
    }
#define MIXER_HOOK MIXER_L0 MIXER_L1


#ifdef PROBE_GU
#define PROBE_GU_X(...) __VA_ARGS__
#else
#define PROBE_GU_X(...)
#endif
#ifdef PROBE_ATT
#define PROBE_ATT_X(...) __VA_ARGS__
#else
#define PROBE_ATT_X(...)
#endif
#ifdef PROBE_GLA
#define PROBE_GLA_X(...) __VA_ARGS__
#else
#define PROBE_GLA_X(...)
#endif
#ifdef PROBE_ELT
#define PROBE_ELT_X(...) __VA_ARGS__
#else
#define PROBE_ELT_X(...)
#endif
#ifdef PROBE_P0
#define PROBE_P0_X(...) __VA_ARGS__
#else
#define PROBE_P0_X(...)
#endif
#define PH_BEGIN { int tid = (int)threadIdx.x; asm volatile("" : "+v"(tid)); const int lane = tid & 63; const int wave = __builtin_amdgcn_readfirstlane(tid >> 6); const int gw = blockIdx.x * NWAVES + wave; (void)lane; (void)gw; (void)wave;
#define PH_END } { XcdBarrier b_; b_.bar = (unsigned*)a.ws; b_.x = xb_xcc_id(); b_.st = (volatile LAS unsigned*)(lds + 131072 + 320) + 8; xcd_barrier(b_); }
#define GEMM_PH(EPI, Aptr, Bptr, Mrows, Ncols, Kdim, ...) PH_BEGIN { int kx_ = (Kdim); asm volatile("" : "+s"(kx_)); pg8::Gemm g{(Aptr), (Bptr), (Mrows), (Ncols), kx_}; pg8::StaticOrder S; S.init((Mrows), (Ncols), G, (int)blockIdx.x); \
    EPI E{__VA_ARGS__}; pg8::gemm_phase<EPI, pg8::StaticOrder, true, true>(lds, g, S, E, tid); } PH_END

__global__ void __launch_bounds__(NTHR, 2) mega(Args a) {
    extern __shared__ __attribute__((aligned(16))) unsigned char lds_[];
    cg::grid_group grid = cg::this_grid();
    LAS unsigned char* lds = (LAS unsigned char*)lds_;
    const int G = gridDim.x, NGW = G * NWAVES;
    unsigned char* ws = a.ws;
    float* XL = a.out; float* XC = (float*)(ws + O_XC);
    bf16* H = (bf16*)(ws + O_H); bf16* HID = (bf16*)(ws + O_HID);
    const float* MOD = (const float*)(ws + O_MOD);

    { volatile LAS unsigned* misc = (volatile LAS unsigned*)(lds + 131072 + 320); if (threadIdx.x < 32) misc[threadIdx.x] = 0u; }
    __syncthreads();
    (void)xcd_barrier_post((unsigned*)ws, (volatile LAS unsigned*)(lds + 131072 + 320) + 8);
    if (gridDim.x == 0x7fffffffu) grid.sync();
    PH_BEGIN phase0(a, lds, tid, lane, wave, G); PH_END
    PROBE_P0_X(PH_BEGIN phase0(a, lds, tid, lane, wave, G); PH_END)
    PH_BEGIN phase_modreduce(a, tid, G); PH_END
#ifdef PROBE_SYNC
    for (int i_ = 0; i_ < 40; ++i_) { PH_BEGIN PH_END }
#endif

#pragma unroll 1
    for (int l = 0; l < 2; ++l) {
        const float* modl = MOD + (size_t)l * 9 * 9216;
        const float* ng = a.in[l == 0 ? 4 : 24];
#pragma unroll 1
        for (int f = 0; f < 2; ++f) {
            const int sub = 2 * f;
            const int nrows = (l == 1 && f == 1) ? NLAT : NTOK;
            const float* xil = (l == 0 && f == 0) ? a.in[0] : XL; const float* xic = (l == 0 && f == 0) ? a.in[2] : XC;
            PH_BEGIN phase_norm(xil, xic, nrows, ng + sub * DM, modl, sub, H, lane, gw, NGW); PH_END
            PROBE_ELT_X(PH_BEGIN phase_norm(xil, xic, nrows, ng + sub * DM, modl, sub, H, lane, gw, NGW); PH_END)
            GEMM_PH(pg8::EpiSwiglu, H, (const bf16*)(ws + (l == 0 ? (f == 0 ? O_GU0A : O_GU0B) : (f == 0 ? O_GU1A : O_GU1B))), nrows, 2 * DFF, DM, HID, DFF)
            PROBE_GU_X(GEMM_PH(pg8::EpiSwiglu, H, (const bf16*)(ws + (l == 0 ? (f == 0 ? O_GU0A : O_GU0B) : (f == 0 ? O_GU1A : O_GU1B))), nrows, 2 * DFF, DM, HID, DFF))
            GEMM_PH(pg8::EpiResid, HID, (const bf16*)(ws + (l == 0 ? (f == 0 ? O_DN0A : O_DN0B) : (f == 0 ? O_DN1A : O_DN1B))), nrows, DM, DFF, xil, xic, XL, XC, modl + (3 * sub + 2) * DM, 0.5f)
            if (f == 0) {
                MIXER_HOOK
            }
        }
    }
}

extern "C" void kernel_launch(void* const* d_in, const int* in_sizes, int n_in, void* d_out, int out_size, void* d_ws, size_t ws_size, hipStream_t stream) {
    static int grid = 0;
    if (grid == 0) {
        int dev = 0, cus = 0, per_cu = 0;
        if (n_in != 38 || ws_size < WS_NEED) { fprintf(stderr, "kernel_launch: n_in %d ws %zu need %zu\n", n_in, ws_size, (size_t)WS_NEED); grid = -1; return; }
        if (hipGetDevice(&dev) != hipSuccess || hipDeviceGetAttribute(&cus, hipDeviceAttributeMultiprocessorCount, dev) != hipSuccess) { grid = -1; return; }
        if (hipFuncSetAttribute((const void*)mega, hipFuncAttributeMaxDynamicSharedMemorySize, LDS_BYTES) != hipSuccess) { fprintf(stderr, "kernel_launch: hipFuncSetAttribute failed\n"); grid = -1; return; }
        if (hipOccupancyMaxActiveBlocksPerMultiprocessor(&per_cu, (const void*)mega, NTHR, LDS_BYTES) != hipSuccess || per_cu < 1) { fprintf(stderr, "kernel_launch: occupancy query %d\n", per_cu); per_cu = 1; (void)hipGetLastError(); }
        grid = cus * per_cu;
    }
    if (grid < 0) return;
    if (hipMemsetAsync(d_ws, 0, 16384, stream) != hipSuccess)     { fprintf(stderr, "kernel_launch: memset failed\n"); return; }
    Args a{};
    for (int i = 0; i < 38; ++i) a.in[i] = (const float*)d_in[i];
    a.out = (float*)d_out; a.ws = (unsigned char*)d_ws;
    void* args[] = {&a};
    hipError_t e = hipLaunchCooperativeKernel((void*)mega, dim3(grid), dim3(NTHR), args, LDS_BYTES, stream);
    if (e != hipSuccess) fprintf(stderr, "cooperative launch failed: %s (grid %d)\n", hipGetErrorString(e), grid);
}
```

```cpp
#include <hip/hip_runtime.h>
#include <hip/hip_cooperative_groups.h>
#include <cstdio>
#include <cstdint>
namespace cg = cooperative_groups;
namespace pg8 {
#define PG8_LAS __attribute__((address_space(3)))
typedef unsigned short bf16_t;
typedef short bf16x8 __attribute__((ext_vector_type(8)));
typedef float f32x4 __attribute__((ext_vector_type(4)));
typedef unsigned u32x4 __attribute__((ext_vector_type(4)));
constexpr int BM = 256, BK = 64, HALF = 128, HTB = HALF * BK * 2  , STAGE_BYTES = 8 * HTB, NXCD = 8, WGM = 8;

__host__ __device__ __forceinline__ int lds_byte(int r, int c) { const int st = (r >> 4) * 2 + (c >> 5), rr = r & 15, cc = c & 31, ob = rr * 64 + cc * 2; return st * 1024 + (ob ^ (((ob >> 9) & 1) << 5)); }
__host__ __device__ __forceinline__ void stage_rc(int b, int& R, int& C) { const int st = b / 1024, sb = b % 1024, swz = sb ^ (((sb >> 9) & 1) << 5); R = (st >> 1) * 16 + swz / 64; C = (st & 1) * 32 + (swz % 64) / 2; }
__host__ __device__ __forceinline__ int perm32(int rho) { const int n = rho >> 4, i = rho & 15; return 8 * (i >> 2) + 4 * n + (i & 3); }

struct Unit { int pm, pn; };
struct Gemm { const bf16_t* A; const bf16_t* Bt; int M, N, K; };

struct StaticOrder {
    int nM, nN, nwg, G, c;
    __host__ __device__ void init(int M, int N, int G_, int c_) { nM = M / BM; nN = N / BM; nwg = nM * nN; G = G_; c = c_; }
    __host__ __device__ bool next(int i, Unit& u) const {
        const long L = (long)i * G + c; if (L >= nwg) return false;
        int wgid = (int)L; { const int q = nwg / NXCD, r = nwg % NXCD, xcd = wgid % NXCD, off = wgid / NXCD; wgid = (xcd < r ? xcd * (q + 1) : r * (q + 1) + (xcd - r) * q) + off; }
        const int nig = WGM * nN, gid = wgid / nig, fm = gid * WGM, gsz = (nM - fm) < WGM ? (nM - fm) : WGM;
        u.pm = fm + ((wgid % nig) % gsz); u.pn = (wgid % nig) / gsz; return true;
    }
    __device__ __forceinline__ void a_ready(const Unit&) const {}
    __device__ __forceinline__ void done(const Unit&) const {}
};

__device__ __forceinline__ unsigned f2bf_(float f) { unsigned u = __builtin_bit_cast(unsigned, f); return (u + 0x7fffu + ((u >> 16) & 1u)) >> 16; }
typedef __bf16 bf16v2_e __attribute__((ext_vector_type(2)));
typedef float f32x2_e __attribute__((ext_vector_type(2)));
__device__ __forceinline__ unsigned pk2_(float lo, float hi) { return __builtin_bit_cast(unsigned, __builtin_convertvector((f32x2_e){lo, hi}, bf16v2_e)); }
__device__ __forceinline__ float silu_(float x) { return x * __builtin_amdgcn_rcpf(1.0f + __builtin_amdgcn_exp2f(-1.4426950408889634f * x)); }
constexpr float GATE_SC = 0.0625f * 1.4426950408889634f;
__device__ __forceinline__ float logsig_(float z) { return fminf(z, 0.f) - __logf(1.0f + __expf(-fabsf(z))); }

struct EpiSwiglu {
    static constexpr bool PERM = true, AFTER_DRAIN = false;
    bf16_t* O; int ldc;
    __device__ __forceinline__ void operator()(const f32x4 (&acc)[2][2][4][2], const Unit& u, int wr, int wc, int fr, int fq) const {
        const int row0 = u.pm * BM + wr * 64 + fr, col0 = u.pn * HALF + wc * 32 + 8 * fq;
#pragma unroll
        for (int ai = 0; ai < 2; ++ai)
#pragma unroll
            for (int m = 0; m < 4; ++m) {
                bf16_t* p = O + (size_t)(row0 + ai * HALF + m * 16) * ldc + col0;
                const f32x4 g0 = acc[ai][0][m][0], g1 = acc[ai][0][m][1], u0 = acc[ai][1][m][0], u1 = acc[ai][1][m][1];
                u32x4 w;
                w.x = pk2_(silu_(g0[0]) * u0[0], silu_(g0[1]) * u0[1]); w.y = pk2_(silu_(g0[2]) * u0[2], silu_(g0[3]) * u0[3]);
                w.z = pk2_(silu_(g1[0]) * u1[0], silu_(g1[1]) * u1[1]); w.w = pk2_(silu_(g1[2]) * u1[2], silu_(g1[3]) * u1[3]);
                *(u32x4*)p = w;
            }
    }
};
struct EpiResid {
    static constexpr bool PERM = false, AFTER_DRAIN = false;
    const float* xin_l; const float* xin_c; float* xout_l; float* xout_c; const float* gate; float coef;
    __device__ __forceinline__ void operator()(const f32x4 (&acc)[2][2][4][2], const Unit& u, int wr, int wc, int fr, int fq) const {
        const int rowbase = u.pm * BM; const bool isc = rowbase >= 65536; const int b = isc ? 8 : (rowbase >> 13);
        const float* xi = isc ? xin_c : xin_l; float* xo = isc ? xout_c : xout_l;
        const int lrow0 = (isc ? rowbase - 65536 : rowbase) + wr * 64 + fr; const int col0 = u.pn * BM + wc * 32 + 4 * fq;
        const float* gp = gate + (size_t)b * 9216 + col0;
#pragma unroll
        for (int bj = 0; bj < 2; ++bj)
#pragma unroll
            for (int n = 0; n < 2; ++n) {
                const f32x4 gv = *(const f32x4*)(gp + bj * HALF + n * 16) * coef;
#pragma unroll
                for (int ai = 0; ai < 2; ++ai)
#pragma unroll
                    for (int m = 0; m < 4; ++m) {
                        const size_t off = (size_t)(lrow0 + ai * HALF + m * 16) * 1024 + col0 + bj * HALF + n * 16;
                        const f32x4 xv = *(const f32x4*)(xi + off);
                        *(f32x4*)(xo + off) = xv + gv * acc[ai][bj][m][n];
                    }
            }
    }
};
template <int MODE> struct EpiBf16P {
    static constexpr bool PERM = true, AFTER_DRAIN = false;
    bf16_t* O; int ldc; const float* bias_f; const float* bias_b; float qscale;
    __device__ __forceinline__ void operator()(const f32x4 (&acc)[2][2][4][2], const Unit& u, int wr, int wc, int fr, int fq) const {
        const int row0 = u.pm * BM + wr * 64 + fr, col0 = u.pn * BM + wc * 32 + 8 * fq;
        int mode = 0; const float* bp = bias_f;
        if (MODE == 1) { if (u.pn >= 6 && u.pn < 10) { mode = 1; bp = (u.pn < 8) ? (bias_f + (col0 - 1536)) : (bias_b + (col0 - 2048)); } else if (u.pn >= 10 && u.pn < 12) mode = 2; }
#pragma unroll
        for (int bj = 0; bj < 2; ++bj) {
            f32x4 b0 = (f32x4){0.f, 0.f, 0.f, 0.f}, b1 = b0;
            if (MODE == 1 && mode == 1) { b0 = *(const f32x4*)(bp + bj * HALF); b1 = *(const f32x4*)(bp + bj * HALF + 4); }
#pragma unroll
            for (int ai = 0; ai < 2; ++ai)
#pragma unroll
                for (int m = 0; m < 4; ++m) {
                    f32x4 v0 = acc[ai][bj][m][0], v1 = acc[ai][bj][m][1];
                    if (MODE == 1) {
                        if (mode == 1) {
                            v0 = v0 + b0; v1 = v1 + b1;
#pragma unroll
                            for (int e = 0; e < 4; ++e) { v0[e] = logsig_(v0[e]) * GATE_SC; v1[e] = logsig_(v1[e]) * GATE_SC; }
                        } else if (mode == 2) { v0 = v0 * qscale; v1 = v1 * qscale; }
                    }
                    u32x4 w; w.x = pk2_(v0[0], v0[1]); w.y = pk2_(v0[2], v0[3]); w.z = pk2_(v1[0], v1[1]); w.w = pk2_(v1[2], v1[3]);
                    *(u32x4*)(O + (size_t)(row0 + ai * HALF + m * 16) * ldc + col0 + bj * HALF) = w;
                }
        }
    }
};
template <class Epi, class Sched, bool ALIGN_EPI = false, bool SP2 = false>
__device__ __forceinline__ void gemm_phase(PG8_LAS unsigned char* lds, const Gemm g, const Sched& S, const Epi& E, int tid_in) {
    const int tid = tid_in, wid = __builtin_amdgcn_readfirstlane(tid >> 6), lane = tid & 63, wr = wid >> 2, wc = wid & 3, fr = lane & 15, fq = lane >> 4;
    const int K = g.K, nt = K / BK;
    unsigned voffA[2], voffB[2];
#pragma unroll
    for (int i = 0; i < 2; ++i) { int R, C; stage_rc(tid * 16 + i * 8192, R, C); const int Rb = Epi::PERM ? ((R & ~31) + perm32(R & 31)) : R;
        voffA[i] = (unsigned)(R * K + C) * 2u; voffB[i] = (unsigned)(Rb * K + C) * 2u; }
    const size_t kstep = (size_t)(BK * 2);
    const size_t hstep = (size_t)HALF * K * 2;
    const size_t tstep = 2 * hstep;
    const unsigned ldsw = (unsigned)wid * 1024u;
    const int aoff = lds_byte(wr * 64 + fr, fq * 8), boff = lds_byte(wc * 32 + fr, fq * 8);
#define PG8_SA(b, h) (((b) * 2 + (h)) * HTB)
#define PG8_SB(b, h) ((4 + (b) * 2 + (h)) * HTB)
#define PG8_STAGE(bufoff, gbase, voff) do { _Pragma("unroll") for (int _i = 0; _i < 2; ++_i) \
        __builtin_amdgcn_global_load_lds((const unsigned*)((const char*)(gbase) + (voff)[_i]), (PG8_LAS unsigned*)(lds + (bufoff) + ldsw + _i * 8192), 16, 0, 0); } while (0)
#define PG8_LDA(dst, b, h) do { _Pragma("unroll") for (int m = 0; m < 4; ++m) _Pragma("unroll") for (int k = 0; k < 2; ++k) dst[m][k] = *(const PG8_LAS bf16x8*)(lds + PG8_SA(b, h) + aoff + m * 2048 + k * 1024); } while (0)
#define PG8_LDB(dst, b, h) do { _Pragma("unroll") for (int n = 0; n < 2; ++n) _Pragma("unroll") for (int k = 0; k < 2; ++k) dst[n][k] = *(const PG8_LAS bf16x8*)(lds + PG8_SB(b, h) + boff + n * 2048 + k * 1024); } while (0)
#define PG8_MMA(ai, bj, At, Bt) do { __builtin_amdgcn_s_setprio(1); _Pragma("unroll") for (int m = 0; m < 4; ++m) _Pragma("unroll") for (int n = 0; n < 2; ++n) _Pragma("unroll") for (int k = 0; k < 2; ++k) \
        acc[ai][bj][m][n] = __builtin_amdgcn_mfma_f32_16x16x32_bf16(Bt[n][k], At[m][k], acc[ai][bj][m][n], 0, 0, 0); __builtin_amdgcn_s_setprio(0); } while (0)
#define PG8_WAIT_V(n) asm volatile("s_waitcnt vmcnt(" #n ")" ::: "memory")
#define PG8_WAIT_L(n) asm volatile("s_waitcnt lgkmcnt(" #n ")" ::: "memory")
#define PG8_BAR __builtin_amdgcn_s_barrier()
#define PG8_SCHED __builtin_amdgcn_sched_barrier(0)
    Unit cur, nxt; int ui = 0;
    if (!S.next(0, cur)) return;
    f32x4 acc[2][2][4][2];
#pragma unroll
    for (int a = 0; a < 2; ++a)
#pragma unroll
        for (int b = 0; b < 2; ++b)
#pragma unroll
            for (int m = 0; m < 4; ++m)
#pragma unroll
                for (int n = 0; n < 2; ++n) acc[a][b][m][n] = (f32x4){0.f, 0.f, 0.f, 0.f};
    bf16x8 At[4][2], B0[2][2], B1[2][2];
    const char* cA = (const char*)g.A + (size_t)cur.pm * tstep; const char* cB = (const char*)g.Bt + (size_t)cur.pn * tstep;
    S.a_ready(cur);
    if constexpr (SP2) {
        PG8_STAGE(PG8_SB(0, 0), cB, voffB); PG8_STAGE(PG8_SB(0, 1), cB + hstep, voffB); PG8_STAGE(PG8_SA(0, 0), cA, voffA); PG8_STAGE(PG8_SA(0, 1), cA + hstep, voffA);
        if (wr == 1) PG8_BAR;
        PG8_WAIT_V(2); PG8_BAR;
        PG8_STAGE(PG8_SB(1, 0), cB + kstep, voffB); PG8_STAGE(PG8_SA(1, 0), cA + kstep, voffA); PG8_STAGE(PG8_SB(1, 1), cB + hstep + kstep, voffB);
        PG8_WAIT_V(6); PG8_BAR;
    } else {
        PG8_STAGE(PG8_SB(0, 0), cB, voffB); PG8_STAGE(PG8_SA(0, 0), cA, voffA); PG8_STAGE(PG8_SB(0, 1), cB + hstep, voffB); PG8_STAGE(PG8_SA(0, 1), cA + hstep, voffA);
        if (wr == 1) PG8_BAR;
        PG8_WAIT_V(4); PG8_BAR;
        PG8_STAGE(PG8_SB(1, 0), cB + kstep, voffB); PG8_STAGE(PG8_SA(1, 0), cA + kstep, voffA); PG8_STAGE(PG8_SB(1, 1), cB + hstep + kstep, voffB);
        PG8_WAIT_V(6); PG8_BAR;
    }
    for (;;) {
        const bool has_next = S.next(ui + 1, nxt);
        const char* nA = has_next ? (const char*)g.A + (size_t)nxt.pm * tstep : cA; const char* nB = has_next ? (const char*)g.Bt + (size_t)nxt.pn * tstep : cB;
        for (int t = 0; t < nt; t += 2) {
            const bool last = (t == nt - 2);
            const char* a1 = cA + (size_t)(t + 1) * kstep;
            const char* a2 = last ? nA : cA + (size_t)(t + 2) * kstep; const char* b2 = last ? nB : cB + (size_t)(t + 2) * kstep;
            const char* a3 = a2 + kstep; const char* b3 = b2 + kstep;
            if (last && has_next) S.a_ready(nxt);
            if constexpr (SP2) {
            PG8_LDB(B0, 0, 0); PG8_LDB(B1, 0, 1); PG8_SCHED; PG8_LDA(At, 0, 0); PG8_STAGE(PG8_SA(1, 1), a1 + hstep, voffA);
            PG8_WAIT_V(8); PG8_WAIT_L(0); PG8_BAR; PG8_MMA(0, 0, At, B0); PG8_MMA(0, 1, At, B1); PG8_BAR; PG8_SCHED;
            PG8_LDA(At, 0, 1); PG8_STAGE(PG8_SB(0, 0), b2, voffB); PG8_STAGE(PG8_SB(0, 1), b2 + hstep, voffB); PG8_STAGE(PG8_SA(0, 0), a2, voffA);
            PG8_WAIT_V(8); PG8_WAIT_L(0); PG8_BAR; PG8_MMA(1, 0, At, B0); PG8_MMA(1, 1, At, B1); PG8_BAR; PG8_SCHED;
            PG8_LDB(B0, 1, 0); PG8_LDB(B1, 1, 1); PG8_SCHED; PG8_LDA(At, 1, 0); PG8_STAGE(PG8_SA(0, 1), a2 + hstep, voffA);
            PG8_WAIT_V(8); PG8_WAIT_L(0); PG8_BAR; PG8_MMA(0, 0, At, B0); PG8_MMA(0, 1, At, B1); PG8_BAR; PG8_SCHED;
            PG8_LDA(At, 1, 1); PG8_STAGE(PG8_SB(1, 0), b3, voffB); PG8_STAGE(PG8_SB(1, 1), b3 + hstep, voffB); PG8_STAGE(PG8_SA(1, 0), a3, voffA);
            PG8_WAIT_V(8); PG8_WAIT_L(0); PG8_BAR; PG8_MMA(1, 0, At, B0); PG8_MMA(1, 1, At, B1); PG8_BAR; PG8_SCHED;
            } else {
            PG8_LDB(B0, 0, 0); PG8_SCHED; PG8_LDA(At, 0, 0); PG8_STAGE(PG8_SA(1, 1), a1 + hstep, voffA);
            PG8_WAIT_L(8); PG8_BAR; PG8_WAIT_L(0); PG8_MMA(0, 0, At, B0); PG8_BAR; PG8_SCHED;
            PG8_LDB(B1, 0, 1); PG8_STAGE(PG8_SB(0, 0), b2, voffB);
            PG8_BAR; PG8_WAIT_L(0); PG8_MMA(0, 1, At, B1); PG8_BAR;
            PG8_LDA(At, 0, 1); PG8_STAGE(PG8_SA(0, 0), a2, voffA);
            PG8_BAR; PG8_WAIT_L(0); PG8_MMA(1, 0, At, B0); PG8_BAR; PG8_SCHED;
            PG8_STAGE(PG8_SB(0, 1), b2 + hstep, voffB);
            PG8_WAIT_V(6); PG8_BAR; PG8_MMA(1, 1, At, B1); PG8_BAR;
            PG8_LDB(B0, 1, 0); PG8_SCHED; PG8_LDA(At, 1, 0); PG8_STAGE(PG8_SA(0, 1), a2 + hstep, voffA);
            PG8_WAIT_L(8); PG8_BAR; PG8_WAIT_L(0); PG8_MMA(0, 0, At, B0); PG8_BAR; PG8_SCHED;
            PG8_LDB(B1, 1, 1); PG8_STAGE(PG8_SB(1, 0), b3, voffB);
            PG8_BAR; PG8_WAIT_L(0); PG8_MMA(0, 1, At, B1); PG8_BAR;
            PG8_LDA(At, 1, 1); PG8_STAGE(PG8_SA(1, 0), a3, voffA);
            PG8_BAR; PG8_WAIT_L(0); PG8_MMA(1, 0, At, B0); PG8_BAR; PG8_SCHED;
            PG8_STAGE(PG8_SB(1, 1), b3 + hstep, voffB);
            PG8_WAIT_V(6); PG8_BAR; PG8_MMA(1, 1, At, B1); PG8_BAR;
            }
        }
        if constexpr (ALIGN_EPI) { if (wr == 0) PG8_BAR; }
        if constexpr (!Epi::AFTER_DRAIN) { E(acc, cur, wr, wc, fr, fq); S.done(cur); }
        if (!has_next) break;
#pragma unroll
        for (int a = 0; a < 2; ++a)
#pragma unroll
            for (int b = 0; b < 2; ++b)
#pragma unroll
                for (int m = 0; m < 4; ++m)
#pragma unroll
                    for (int n = 0; n < 2; ++n) acc[a][b][m][n] = (f32x4){0.f, 0.f, 0.f, 0.f};
        cur = nxt; cA = nA; cB = nB; ++ui;
        if constexpr (ALIGN_EPI) { if (wr == 1) PG8_BAR; }
    }
    PG8_WAIT_V(0);
    if constexpr (!ALIGN_EPI) { if (wr == 0) PG8_BAR; }
    PG8_BAR;
    if constexpr (Epi::AFTER_DRAIN) { E.fused(acc, cur, wr, wc, fr, fq, lds, wid, lane); S.done(cur); }
#undef PG8_SA
#undef PG8_SB
#undef PG8_STAGE
#undef PG8_LDA
#undef PG8_LDB
#undef PG8_MMA
#undef PG8_WAIT_V
#undef PG8_WAIT_L
#undef PG8_BAR
#undef PG8_SCHED
}
}

#define LAS __attribute__((address_space(3)))
typedef unsigned short bf16;
typedef unsigned v4u __attribute__((ext_vector_type(4)));
typedef unsigned v2u __attribute__((ext_vector_type(2)));
typedef float f32x4 __attribute__((ext_vector_type(4)));
typedef float f32x16 __attribute__((ext_vector_type(16)));
typedef short bf16x8 __attribute__((ext_vector_type(8)));
typedef short s16x4 __attribute__((ext_vector_type(4)));

constexpr int NWAVES = 8, NTHR = 512;
constexpr int NLAT = 65536, NCTX = 2048, NTOK = NLAT + NCTX, DM = 1024, DFF = 2816, SEQ = 8192, CTXL = 256, NKEY = SEQ + CTXL;
constexpr int LDS_BYTES = 147456;
constexpr int ZW0 = 1280;
constexpr int UPK = 384, UPN = 1792;
constexpr int ZW1 = 4096;

constexpr size_t SZ_GU = (size_t)2 * DFF * DM * 2, SZ_DN = (size_t)DM * DFF * 2, SZ_IN0 = (size_t)ZW0 * DM * 2, SZ_UP = (size_t)UPN * UPK * 2, SZ_OUT = (size_t)DM * DM * 2, SZ_IN1 = (size_t)ZW1 * DM * 2;
constexpr size_t CTL_BYTES = 65536;
constexpr size_t O_GU0A = CTL_BYTES, O_DN0A = O_GU0A + SZ_GU, O_GU0B = O_DN0A + SZ_DN, O_DN0B = O_GU0B + SZ_GU, O_GU1A = O_DN0B + SZ_DN, O_DN1A = O_GU1A + SZ_GU, O_GU1B = O_DN1A + SZ_DN, O_DN1B = O_GU1B + SZ_GU;
constexpr size_t O_IN0 = O_DN1B + SZ_DN, O_UP = O_IN0 + SZ_IN0, O_OUT0 = O_UP + SZ_UP, O_IN1 = O_OUT0 + SZ_OUT, O_OUT1 = O_IN1 + SZ_IN1;
constexpr size_t O_MODP = O_OUT1 + SZ_OUT, SZ_MODP = (size_t)2 * 16 * 9 * 9216 * 4, O_MOD = O_MODP + SZ_MODP, SZ_MOD = (size_t)2 * 9 * 9216 * 4;
constexpr size_t O_XC = O_MOD + SZ_MOD, SZ_XC = (size_t)NCTX * DM * 4;
constexpr size_t O_H = O_XC + SZ_XC, SZ_H = (size_t)NTOK * DM * 2;
constexpr size_t O_R = O_H + SZ_H;
constexpr size_t O_HID = O_R, SZ_HID = (size_t)NTOK * DFF * 2;
constexpr size_t O_Z0 = O_R, SZ_Z0 = (size_t)NTOK * UPN * 2;
constexpr size_t O_CN = O_Z0 + SZ_Z0, SZ_CN = (size_t)NTOK * UPK * 2;
constexpr size_t O_QM = O_CN + SZ_CN, SZ_QM = (size_t)NTOK * 768 * 2;
constexpr size_t O_KM = O_QM + SZ_QM, SZ_KM = (size_t)8 * 8 * NKEY * 96 * 2;
constexpr size_t O_VM = O_KM + SZ_KM, SZ_VM = (size_t)8 * 8 * NKEY * 64 * 2;
constexpr size_t O_KW = O_VM + SZ_VM, SZ_KW = (size_t)8 * 2 * NKEY * 64 * 2;
constexpr size_t O_VW = O_KW + SZ_KW;
constexpr size_t O_QW = O_VW + SZ_KW, SZ_QW = (size_t)NTOK * 512 * 2;
constexpr size_t O_END0 = O_QW + SZ_QW;
constexpr size_t O_Z1 = O_R, SZ_Z1 = (size_t)NTOK * ZW1 * 2;
constexpr size_t O_OB = O_Z1 + SZ_Z1, SZ_OB = (size_t)NLAT * DM * 2;
constexpr size_t O_END1 = O_OB + SZ_OB;
constexpr size_t WS_NEED = (O_END1 > O_END0 ? O_END1 : O_END0) > (O_HID + SZ_HID) ? (O_END1 > O_END0 ? O_END1 : O_END0) : (O_HID + SZ_HID);
static_assert(O_R % 256 == 0 && O_CN % 256 == 0 && O_OB % 256 == 0, "alignment");

#define GAS __attribute__((address_space(1)))
#define LDS_WAIT() asm volatile("s_waitcnt lgkmcnt(0)" ::: "memory")
typedef __bf16 bf16v2_t __attribute__((ext_vector_type(2)));
typedef float f32x2_t __attribute__((ext_vector_type(2)));
__device__ __forceinline__ unsigned pk2(float lo, float hi) { return __builtin_bit_cast(unsigned, __builtin_convertvector((f32x2_t){lo, hi}, bf16v2_t)); }
__device__ __forceinline__ unsigned f2bf(float f) { return pk2(f, f) & 0xffffu; }
__device__ __forceinline__ float bf2f(unsigned short h) { return __builtin_bit_cast(float, (unsigned)h << 16); }
__device__ __forceinline__ float bflo(unsigned w) { return __builtin_bit_cast(float, w << 16); }
__device__ __forceinline__ float bfhi(unsigned w) { return __builtin_bit_cast(float, w & 0xffff0000u); }
__device__ __forceinline__ float wave_sum(float v) {
#pragma unroll
    for (int o = 1; o < 64; o <<= 1) v += __shfl_xor(v, o);
    return v;
}
__device__ __forceinline__ float silu_f(float x) { return x * __builtin_amdgcn_rcpf(1.0f + __builtin_amdgcn_exp2f(-1.4426950408889634f * x)); }

struct Args { const float* in[38]; float* out; unsigned char* ws; };

__device__ __forceinline__ void tr_item(const float* W, int ldw, int k0, int n0, bf16* WT, int ldt, int drow0, int dcol0, LAS float* scr, int lane) {
#pragma unroll 8
    for (int i = 0; i < 32; ++i) { const int kk = 2 * i + (lane >> 5); scr[kk * 33 + (lane & 31)] = W[(size_t)(k0 + kk) * ldw + n0 + (lane & 31)]; }
    LDS_WAIT(); asm volatile("" ::: "memory");
    const int c = lane & 7;
#pragma unroll
    for (int j = 0; j < 4; ++j) { const int n = (lane >> 3) + 8 * j; const LAS float* s = scr + (8 * c) * 33 + n;
        v4u o; o.x = pk2(s[0 * 33], s[1 * 33]); o.y = pk2(s[2 * 33], s[3 * 33]); o.z = pk2(s[4 * 33], s[5 * 33]); o.w = pk2(s[6 * 33], s[7 * 33]);
        *(v4u*)(WT + (size_t)(drow0 + n) * ldt + dcol0 + 8 * c) = o; }
    LDS_WAIT(); asm volatile("" ::: "memory");
}
__device__ __forceinline__ void tr_matrix(const float* W, int K, int N, bf16* WT, int mode, LAS float* scr, int lane, int gw, int NGW) {
    const int nblk = N / 32, items = (K / 64) * nblk;
    for (int it = gw; it < items; it += NGW) {
        const int kb = it / nblk, nb = it % nblk, n0 = nb * 32;
        int drow = n0;
        if (mode == 1) { const int half = n0 >= DFF ? 1 : 0, j = n0 - half * DFF; drow = (j >> 7) * 256 + half * 128 + (j & 127); }
        tr_item(W, N, kb * 64, n0, WT, K, drow, kb * 64, scr, lane);
    }
}

__device__ __forceinline__ void phase0(const Args& a, LAS unsigned char* lds, int tid, int lane, int wave, int G) {
    unsigned char* ws = a.ws;
    {
        LAS float* sl = (LAS float*)lds;
        for (int item = blockIdx.x; item < 2 * 16 * 18; item += G) {
            const int l = item / (16 * 18), kc = (item / 18) % 16, cb = item % 18;
            __syncthreads();
            for (int e = tid; e < 9 * 64; e += NTHR) { const int b = e / 64, k = e % 64; const float cv = (b < 8) ? a.in[1][b * DM + kc * 64 + k] : a.in[3][kc * 64 + k]; sl[e] = silu_f(cv); }
            __syncthreads();
            const float* wm = a.in[l == 0 ? 5 : 25] + (size_t)(kc * 64) * 9216 + cb * 512 + tid;
            float acc[9];
#pragma unroll
            for (int b = 0; b < 9; ++b) acc[b] = 0.f;
            for (int k = 0; k < 64; ++k) { const float w = wm[(size_t)k * 9216];
#pragma unroll
                for (int b = 0; b < 9; ++b) acc[b] += sl[b * 64 + k] * w; }
            float* mp = (float*)(ws + O_MODP) + ((size_t)(l * 16 + kc) * 9) * 9216 + cb * 512 + tid;
#pragma unroll
            for (int b = 0; b < 9; ++b) mp[(size_t)b * 9216] = acc[b];
        }
        __syncthreads();
    }
    LAS float* scr = (LAS float*)(lds + wave * 16384);
    const int gw = blockIdx.x * NWAVES + wave, NGW = G * NWAVES;
    tr_matrix(a.in[7], DM, 2 * DFF, (bf16*)(ws + O_GU0A), 1, scr, lane, gw, NGW);
    tr_matrix(a.in[9], DM, 2 * DFF, (bf16*)(ws + O_GU0B), 1, scr, lane, gw, NGW);
    tr_matrix(a.in[27], DM, 2 * DFF, (bf16*)(ws + O_GU1A), 1, scr, lane, gw, NGW);
    tr_matrix(a.in[29], DM, 2 * DFF, (bf16*)(ws + O_GU1B), 1, scr, lane, gw, NGW);
    tr_matrix(a.in[8], DFF, DM, (bf16*)(ws + O_DN0A), 0, scr, lane, gw, NGW);
    tr_matrix(a.in[10], DFF, DM, (bf16*)(ws + O_DN0B), 0, scr, lane, gw, NGW);
    tr_matrix(a.in[28], DFF, DM, (bf16*)(ws + O_DN1A), 0, scr, lane, gw, NGW);
    tr_matrix(a.in[30], DFF, DM, (bf16*)(ws + O_DN1B), 0, scr, lane, gw, NGW);
    tr_matrix(a.in[11], DM, 1184, (bf16*)(ws + O_IN0), 0, scr, lane, gw, NGW);
    tr_matrix(a.in[23], DM, DM, (bf16*)(ws + O_OUT0), 0, scr, lane, gw, NGW);
    tr_matrix(a.in[37], DM, DM, (bf16*)(ws + O_OUT1), 0, scr, lane, gw, NGW);
    for (int it = gw; it < 2 * 32; it += NGW) { const int kb = it / 32, nb = it % 32; tr_item(a.in[15], 1024, kb * 64, nb * 32, (bf16*)(ws + O_UP), UPK, nb * 32, kb * 64, scr, lane); }
    for (int it = gw; it < 4 * 24; it += NGW) { const int kb = it / 24, nb = it % 24; tr_item(a.in[14], 768, kb * 64, nb * 32, (bf16*)(ws + O_UP), UPK, 1024 + nb * 32, 128 + kb * 64, scr, lane); }
    for (int it = gw; it < 16 * 97; it += NGW) { const int kb = it / 97, nb = it % 97; if (nb == 48) continue;
        const int drow = nb < 48 ? nb * 32 : (nb < 65 ? 2560 + (nb - 49) * 32 : 3072 + (nb - 65) * 32);
        tr_item(a.in[31], 3104, kb * 64, nb * 32, (bf16*)(ws + O_IN1), DM, drow, kb * 64, scr, lane); }
    const int gt = blockIdx.x * NTHR + tid, NGT = G * NTHR;
    for (int it = gt; it < 1024 * 128; it += NGT) {
        const int n = it >> 7, k8 = (it & 127) * 8; const int dir = n >> 9, nn = n & 511;
        const float* wg = a.in[dir ? 34 : 32] + nn; const float* wi = a.in[31] + (size_t)k8 * 3104 + 1536 + 16 * dir;
        float wr[16];
#pragma unroll
        for (int r = 0; r < 16; ++r) wr[r] = wg[r * 512];
        float o[8];
#pragma unroll
        for (int e = 0; e < 8; ++e) { float s = 0.f;
#pragma unroll
            for (int r = 0; r < 16; ++r) s += wi[(size_t)e * 3104 + r] * wr[r];
            o[e] = s; }
        v4u w; w.x = pk2(o[0], o[1]); w.y = pk2(o[2], o[3]); w.z = pk2(o[4], o[5]); w.w = pk2(o[6], o[7]);
        *(v4u*)((bf16*)(ws + O_IN1) + (size_t)(1536 + n) * DM + k8) = w;
    }
    for (int it = gt; it < 96 * 128; it += NGT) *(v4u*)((bf16*)(ws + O_IN0) + (size_t)1184 * DM + (size_t)it * 8) = (v4u){0u, 0u, 0u, 0u};
    for (int it = gt; it < 1024 * 32; it += NGT) { const int r = it >> 5, c = it & 31; *(v4u*)((bf16*)(ws + O_UP) + (size_t)r * UPK + 128 + c * 8) = (v4u){0u, 0u, 0u, 0u}; }
    for (int it = gt; it < 768 * 16; it += NGT) { const int r = it >> 4, c = it & 15; *(v4u*)((bf16*)(ws + O_UP) + (size_t)(1024 + r) * UPK + c * 8) = (v4u){0u, 0u, 0u, 0u}; }
}
__device__ __forceinline__ void phase_modreduce(const Args& a, int tid, int G) {
    const int gt = blockIdx.x * NTHR + tid, NGT = G * NTHR;
    for (int it = gt; it < 2 * 9 * 9216; it += NGT) {
        const int l = it / (9 * 9216), r = it % (9 * 9216), n = r % 9216;
        const float* mp = (const float*)(a.ws + O_MODP) + (size_t)l * 16 * 9 * 9216 + r;
        float s = a.in[l == 0 ? 6 : 26][n];
        for (int kc = 0; kc < 16; ++kc) s += mp[(size_t)kc * 9 * 9216];
        ((float*)(a.ws + O_MOD))[it] = s;
    }
}
__device__ __forceinline__ void phase_norm(const float* __restrict__ xl, const float* __restrict__ xc, int nrows, const float* ng, const float* modl, int sub, bf16* __restrict__ H, int lane, int gw, int NGW) {
    const int per = (nrows + NGW - 1) / NGW, rb = gw * per, re = (rb + per) < nrows ? (rb + per) : nrows;
    if (rb >= re) return;
    int curb = -1; f32x4 G[4], S0[4];
#pragma unroll
    for (int j = 0; j < 4; ++j) { G[j] = (f32x4){0.f, 0.f, 0.f, 0.f}; S0[j] = G[j]; }
    f32x4 v[4], v1[4];
#define NORM_LD(dst, r_) do { const int rr_ = (r_) < re ? (r_) : re - 1; const float* src_ = rr_ >= NLAT ? xc + (size_t)(rr_ - NLAT) * DM : xl + (size_t)rr_ * DM; const f32x4* xr_ = (const f32x4*)src_ + lane; \
        _Pragma("unroll") for (int j = 0; j < 4; ++j) dst[j] = __builtin_nontemporal_load(xr_ + 64 * j); } while (0)
    NORM_LD(v, rb); NORM_LD(v1, rb + 1);
#pragma unroll 1
    for (int row = rb; row < re; ++row) {
        f32x4 vn[4];
        NORM_LD(vn, row + 2);
        const int b = row >= NLAT ? 8 : (row >> 13);
        if (b != curb) { curb = b;
            const f32x4* gp = (const f32x4*)ng + lane; const f32x4* sh = (const f32x4*)(modl + (size_t)b * 9216 + (3 * sub) * DM) + lane; const f32x4* sc = (const f32x4*)(modl + (size_t)b * 9216 + (3 * sub + 1) * DM) + lane;
#pragma unroll
            for (int j = 0; j < 4; ++j) { G[j] = gp[64 * j] * (1.0f + sc[64 * j]); S0[j] = sh[64 * j]; } }
        float ss = 0.f;
#pragma unroll
        for (int j = 0; j < 4; ++j) ss += (v[j].x * v[j].x + v[j].y * v[j].y) + (v[j].z * v[j].z + v[j].w * v[j].w);
        const float rstd = rsqrtf(wave_sum(ss) * (1.0f / DM) + 1e-6f);
        unsigned long long* o8 = (unsigned long long*)(H + (size_t)row * DM) + lane;
#pragma unroll
        for (int j = 0; j < 4; ++j) { const f32x4 h = v[j] * rstd * G[j] + S0[j];
            o8[64 * j] = (unsigned long long)pk2(h.x, h.y) | ((unsigned long long)pk2(h.z, h.w) << 32); }
#pragma unroll
        for (int j = 0; j < 4; ++j) { v[j] = v1[j]; v1[j] = vn[j]; }
    }
#undef NORM_LD
}
#define XB_TMO      128
#define XB_XCNT(j)  (256  + 64 * (j))
#define XB_XSUB(j)  (1280 + 64 * (j))
#define XB_XGEN(j)  (2304 + 64 * (j))
#define XB_TOP      3328
#define XB_TOPGEN   3392
#define XCD_BAR_WORDS 3456
#define XB_SPIN_CAP (1u << 18)

__device__ __forceinline__ unsigned xb_ld(unsigned* p)              { return __hip_atomic_load(p, __ATOMIC_RELAXED, __HIP_MEMORY_SCOPE_AGENT); }
__device__ __forceinline__ unsigned xb_add(unsigned* p, unsigned v) { return __hip_atomic_fetch_add(p, v, __ATOMIC_RELAXED, __HIP_MEMORY_SCOPE_AGENT); }
__device__ __forceinline__ unsigned xb_xcc_id() { return (unsigned)__builtin_amdgcn_s_getreg((3 << 11) | 20) & 0xFu; }
#define XB_SPIN(cond, bar) do { unsigned _sp = 0; while (cond) { __builtin_amdgcn_s_sleep(1); \
    if ((++_sp & 255u) == 0u) { if (xb_ld(&(bar)[XB_TMO])) break; if (_sp > XB_SPIN_CAP) { atomicAdd(&(bar)[XB_TMO], 1u); break; } } } } while (0)

struct XcdBarrier {
    unsigned* bar; unsigned x;
    volatile LAS unsigned* st;
};

__device__ __forceinline__ XcdBarrier xcd_barrier_post(unsigned* bar, volatile LAS unsigned* st) {
    XcdBarrier b; b.bar = bar; b.x = xb_xcc_id(); b.st = st;
    if (threadIdx.x == 0) (void)xb_add(&bar[XB_XCNT(b.x)], 1u);
    return b;
}
__device__ __forceinline__ void xcd_barrier_complete(unsigned* bar, unsigned x, unsigned& nloc, unsigned& nx) {
    const unsigned G = gridDim.x * gridDim.y * gridDim.z;
    unsigned sum, cnt, mine, sp = 0u;
    for (;;) {
        sum = 0u; cnt = 0u; mine = 0u;
#pragma unroll
        for (unsigned j = 0; j < 16; ++j) { const unsigned c = xb_ld(&bar[XB_XCNT(j)]); sum += c; cnt += (c > 0u) ? 1u : 0u; mine = (j == x) ? c : mine; }
        if (sum == G) break;
        __builtin_amdgcn_s_sleep(1);
        if ((++sp & 255u) == 0u) { if (xb_ld(&bar[XB_TMO])) break; if (sp > XB_SPIN_CAP) { atomicAdd(&bar[XB_TMO], 1u); break; } }
    }
    nloc = mine > 0u ? mine : 1u; nx = cnt > 0u ? cnt : 1u;
}

__device__ __forceinline__ void xcd_barrier(const XcdBarrier& b) {
    asm volatile("s_waitcnt vmcnt(0)" ::: "memory");
    __syncthreads();
    if (threadIdx.x == 0) {
        unsigned* bar = b.bar;
        __builtin_amdgcn_s_waitcnt(0);
        unsigned nloc = b.st[0], nx = b.st[1];
        if (nloc == 0u) { xcd_barrier_complete(bar, b.x, nloc, nx); b.st[0] = nloc; b.st[1] = nx; }
        const unsigned old = xb_add(&bar[XB_XSUB(b.x)], 1u);
        const unsigned gen = old / nloc;
        if (old + 1u == (gen + 1u) * nloc) {
            __builtin_amdgcn_fence(__ATOMIC_RELEASE, "agent");
            asm volatile("s_waitcnt vmcnt(0)" ::: "memory");
            const unsigned og = xb_add(&bar[XB_TOP], 1u);
            const unsigned tg = og / nx;
            if (og + 1u == (tg + 1u) * nx) xb_add(&bar[XB_TOPGEN], 1u);
            else XB_SPIN(xb_ld(&bar[XB_TOPGEN]) == tg, bar);
            __builtin_amdgcn_fence(__ATOMIC_ACQUIRE, "agent");
            xb_add(&bar[XB_XGEN(b.x)], 1u);
            asm volatile("s_waitcnt vmcnt(0)" ::: "memory");
        } else {
            XB_SPIN(xb_ld(&bar[XB_XGEN(b.x)]) == gen, bar);
            __builtin_amdgcn_fence(__ATOMIC_ACQUIRE, "agent");
            asm volatile("s_waitcnt vmcnt(0)" ::: "memory");
        }
    }
    __syncthreads();
}

#define MFMA16(a, b, c) __builtin_amdgcn_mfma_f32_16x16x32_bf16((a), (b), (c), 0, 0, 0)
constexpr int GQS = 136, GTS = 72;
__device__ __forceinline__ void gla_scan(const bf16* Z1, bf16* OF, bf16* OB, LAS unsigned char* lds, int tid, int lane, int wave, int G) {
    LAS bf16* Qd = (LAS bf16*)lds;
    LAS bf16* Ki = Qd + 64 * GQS;
    LAS bf16* KeT = Ki + 64 * GQS;
    LAS bf16* VT = KeT + 128 * GTS;
    LAS bf16* Am = VT + 64 * GTS;
    LAS bf16* ST = Am + 64 * GTS;
    LAS float* dec = (LAS float*)(ST + 64 * GQS);
    const int l15 = lane & 15, l4 = lane >> 4;
    for (int job = blockIdx.x; job < 256; job += G) {
        const int bh_ = 4 * (job & 7) + (job >> 6), sub_ = (job >> 3) & 7;
        const int b = bh_ >> 2, h = bh_ & 3, dir = sub_ >> 2, dvb = sub_ & 3;
        const int sgn = dir ? -1 : 1;
        bf16* Oout = dir ? OB : OF;
        const int dk = 16 * wave + l15, qd = l4;
        const int dke = dk & ~1; const int hsh = (dk & 1) ? 0 : 16;
#define GLA_SEL(x) __builtin_bit_cast(float, ((x) << hsh) & 0xffff0000u)
        const bf16* zk = Z1 + 128 * h + dke; const bf16* zq = Z1 + 2560 + 128 * h + dke; const bf16* zg = Z1 + (dir ? 2048 : 1536) + 128 * h + dke;
        const int tv = tid & 63, dvc = tid >> 6;
        const bf16* zv = Z1 + 512 + 256 * h + 64 * dvb + 8 * dvc;
        f32x4 sacc[4];
#pragma unroll
        for (int i = 0; i < 4; ++i) sacc[i] = (f32x4){0.f, 0.f, 0.f, 0.f};
        unsigned rg[1][16], rq[1][16], rk[1][16]; v4u rv[1];
        int r0 = NLAT + b * 256 + (dir ? 255 : 0);
#define GLA_LOAD(S, rr) do { _Pragma("unroll") for (int i = 0; i < 16; ++i) { const size_t ro = (size_t)((rr) + sgn * (16 * qd + i)) * ZW1; rg[S][i] = *(const unsigned*)(zg + ro); rq[S][i] = *(const unsigned*)(zq + ro); rk[S][i] = *(const unsigned*)(zk + ro); } \
            rv[S] = *(const v4u*)(zv + (size_t)((rr) + sgn * tv) * ZW1); } while (0)
        GLA_LOAD(0, r0);
#pragma unroll 1
        for (int c = 0; c < 132; ++c) {
          { constexpr int S = 0;
            const int rcur = r0;
            __syncthreads();
            { const int dkh = wave >> 2, dvs = wave & 3;
#pragma unroll
              for (int dkt = 0; dkt < 4; ++dkt) { v2u w; w.x = pk2(sacc[dkt][0], sacc[dkt][1]); w.y = pk2(sacc[dkt][2], sacc[dkt][3]);
                  *(LAS v2u*)(ST + (16 * dvs + l15) * GQS + 64 * dkh + 16 * dkt + 4 * l4) = w; } }
#ifdef PROBE_GLA_T2
#pragma unroll 1
            for (int rep_ = 0; rep_ < 2; ++rep_)
#endif
            {
                float p[16]; float run = 0.f;
#pragma unroll
                for (int i = 0; i < 16; ++i) { run += GLA_SEL(rg[S][i]); p[i] = run; }
                const float t0 = __shfl(run, l15), t1 = __shfl(run, l15 + 16), t2 = __shfl(run, l15 + 32), t3 = __shfl(run, l15 + 48);
                const float off = (qd > 0 ? t0 : 0.f) + (qd > 1 ? t1 : 0.f) + (qd > 2 ? t2 : 0.f), bend = (t0 + t1) + (t2 + t3);
                float ke[16]; const float eend = __builtin_amdgcn_exp2f(bend);
                const int dksw = dk ^ (16 * qd);
#pragma unroll
                for (int i = 0; i < 16; ++i) {
                    const float bb = p[i] + off, qv = GLA_SEL(rq[S][i]), kv = GLA_SEL(rk[S][i]);
                    const float ei = __builtin_amdgcn_exp2f(-bb);
                    Qd[(16 * qd + i) * GQS + dksw] = (bf16)pk2(qv * __builtin_amdgcn_exp2f(bb), 0.f);
                    Ki[(16 * qd + i) * GQS + dksw] = (bf16)pk2(kv * ei, 0.f);
                    ke[i] = kv * (eend * ei);
                }
                v4u w0, w1;
                w0.x = pk2(ke[0], ke[1]); w0.y = pk2(ke[2], ke[3]); w0.z = pk2(ke[4], ke[5]); w0.w = pk2(ke[6], ke[7]);
                w1.x = pk2(ke[8], ke[9]); w1.y = pk2(ke[10], ke[11]); w1.z = pk2(ke[12], ke[13]); w1.w = pk2(ke[14], ke[15]);
                *(LAS v4u*)(KeT + dk * GTS + 16 * qd) = w0; *(LAS v4u*)(KeT + dk * GTS + 16 * qd + 8) = w1;
                if (qd == 0) dec[dk] = eend;
                VT[(8 * dvc + 0) * GTS + tv] = (bf16)(rv[S].x & 0xffffu); VT[(8 * dvc + 1) * GTS + tv] = (bf16)(rv[S].x >> 16);
                VT[(8 * dvc + 2) * GTS + tv] = (bf16)(rv[S].y & 0xffffu); VT[(8 * dvc + 3) * GTS + tv] = (bf16)(rv[S].y >> 16);
                VT[(8 * dvc + 4) * GTS + tv] = (bf16)(rv[S].z & 0xffffu); VT[(8 * dvc + 5) * GTS + tv] = (bf16)(rv[S].z >> 16);
                VT[(8 * dvc + 6) * GTS + tv] = (bf16)(rv[S].w & 0xffffu); VT[(8 * dvc + 7) * GTS + tv] = (bf16)(rv[S].w >> 16);
            }
            if (c + 1 < 132) {
                r0 = (c + 1 < 4) ? (NLAT + b * 256 + (dir ? 255 - 64 * (c + 1) : 64 * (c + 1))) : (b * SEQ + (dir ? SEQ - 1 - 64 * (c + 1 - 4) : 64 * (c + 1 - 4)));
                GLA_LOAD(0, r0);
            }
            __syncthreads();
#ifdef PROBE_GLA_T3
#pragma unroll 1
            for (int rep_ = 0; rep_ < 2; ++rep_)
#endif
            if (c >= 4) {
#pragma unroll
                for (int q = 0; q < 2; ++q) {
                    const int tile = 2 * wave + q, ti = tile >> 2, si = tile & 3;
                    f32x4 acc = (f32x4){0.f, 0.f, 0.f, 0.f};
                    if (si <= ti) {
#pragma unroll
                        for (int ks = 0; ks < 4; ++ks) {
                            const bf16x8 A = *(const LAS bf16x8*)(Ki + (16 * si + l15) * GQS + ((32 * ks + 8 * l4) ^ (16 * si)));
                            const bf16x8 B = *(const LAS bf16x8*)(Qd + (16 * ti + l15) * GQS + ((32 * ks + 8 * l4) ^ (16 * ti)));
                            acc = MFMA16(A, B, acc);
                        }
                    }
                    const int t = 16 * ti + l15, s0 = 16 * si + 4 * l4;
                    v2u w; w.x = pk2(s0 + 0 <= t ? acc[0] : 0.f, s0 + 1 <= t ? acc[1] : 0.f); w.y = pk2(s0 + 2 <= t ? acc[2] : 0.f, s0 + 3 <= t ? acc[3] : 0.f);
                    *(LAS v2u*)(Am + t * GTS + s0) = w;
                }
            }
            __syncthreads();
#ifdef PROBE_GLA_T4
#pragma unroll 1
            for (int rep_ = 0; rep_ < 2; ++rep_)
#endif
            if (c >= 4) {
                const int tq = wave >> 2, dvs = wave & 3;
#pragma unroll
                for (int q = 0; q < 2; ++q) {
                    const int tt = 2 * tq + q;
                    f32x4 acc = (f32x4){0.f, 0.f, 0.f, 0.f};
#pragma unroll
                    for (int ks = 0; ks < 2; ++ks) {
                        const bf16x8 A = *(const LAS bf16x8*)(VT + (16 * dvs + l15) * GTS + 32 * ks + 8 * l4);
                        const bf16x8 B = *(const LAS bf16x8*)(Am + (16 * tt + l15) * GTS + 32 * ks + 8 * l4);
                        acc = MFMA16(A, B, acc);
                    }
#pragma unroll
                    for (int ks = 0; ks < 4; ++ks) {
                        const bf16x8 A = *(const LAS bf16x8*)(ST + (16 * dvs + l15) * GQS + 32 * ks + 8 * l4);
                        const bf16x8 B = *(const LAS bf16x8*)(Qd + (16 * tt + l15) * GQS + ((32 * ks + 8 * l4) ^ (16 * tt)));
                        acc = MFMA16(A, B, acc);
                    }
                    const int row = rcur + sgn * (16 * tt + l15);
                    v2u w; w.x = pk2(acc[0], acc[1]); w.y = pk2(acc[2], acc[3]);
                    *(v2u*)(Oout + (size_t)row * DM + 256 * h + 64 * dvb + 16 * dvs + 4 * l4) = w;
                }
            }
            { const int dkh = wave >> 2, dvs = wave & 3;
#pragma unroll
              for (int dkt = 0; dkt < 4; ++dkt) {
                  const int dk0 = 64 * dkh + 16 * dkt;
                  const f32x4 d4 = *(const LAS f32x4*)(dec + dk0 + 4 * l4);
                  sacc[dkt] = sacc[dkt] * d4;
#pragma unroll
                  for (int ks = 0; ks < 2; ++ks) {
                      const bf16x8 A = *(const LAS bf16x8*)(KeT + (dk0 + l15) * GTS + 32 * ks + 8 * l4);
                      const bf16x8 B = *(const LAS bf16x8*)(VT + (16 * dvs + l15) * GTS + 32 * ks + 8 * l4);
                      sacc[dkt] = MFMA16(A, B, sacc[dkt]);
                  }
              } }
          }
        }
#undef GLA_LOAD
#undef GLA_SEL
        __syncthreads();
    }
}
__device__ __forceinline__ void gla_combine(bf16* OF, const bf16* OB, const bf16* Z1, const float* gnorm, int lane, int gw, int NGW) {
    for (int row = gw; row < NLAT; row += NGW) {
        const v4u* pf = (const v4u*)(OF + (size_t)row * DM + 16 * lane); const v4u* pb = (const v4u*)(OB + (size_t)row * DM + 16 * lane);
        const v4u* pg = (const v4u*)(Z1 + (size_t)row * ZW1 + 3072 + 16 * lane);
        const v4u f0 = pf[0], f1 = pf[1], b0 = pb[0], b1 = pb[1], g0 = pg[0], g1 = pg[1];
        const unsigned fw[8] = {f0.x, f0.y, f0.z, f0.w, f1.x, f1.y, f1.z, f1.w}, bw[8] = {b0.x, b0.y, b0.z, b0.w, b1.x, b1.y, b1.z, b1.w}, gwd[8] = {g0.x, g0.y, g0.z, g0.w, g1.x, g1.y, g1.z, g1.w};
        float o[16]; float ss = 0.f;
#pragma unroll
        for (int e = 0; e < 8; ++e) { o[2 * e] = bflo(fw[e]) + bflo(bw[e]); o[2 * e + 1] = bfhi(fw[e]) + bfhi(bw[e]); ss += o[2 * e] * o[2 * e] + o[2 * e + 1] * o[2 * e + 1]; }
        ss += __shfl_xor(ss, 1); ss += __shfl_xor(ss, 2); ss += __shfl_xor(ss, 4); ss += __shfl_xor(ss, 8);
        const float rstd = rsqrtf(ss * (1.0f / 256.0f) + 1e-6f);
        const float* gn = gnorm + 16 * (lane & 15);
        unsigned ow[8];
#pragma unroll
        for (int e = 0; e < 8; ++e) { const float ga = bflo(gwd[e]), gb = bfhi(gwd[e]);
            ow[e] = pk2(o[2 * e] * rstd * gn[2 * e] * silu_f(ga), o[2 * e + 1] * rstd * gn[2 * e + 1] * silu_f(gb)); }
        v4u* po = (v4u*)(OF + (size_t)row * DM + 16 * lane);
        po[0] = (v4u){ow[0], ow[1], ow[2], ow[3]}; po[1] = (v4u){ow[4], ow[5], ow[6], ow[7]};
    }
}

#define MFMA32(a, b, c) __builtin_amdgcn_mfma_f32_32x32x16_bf16((a), (b), (c), 0, 0, 0)
constexpr float LOG2E = 1.4426950408889634f;
constexpr float QS_MLA = 0.10206207261596577f * LOG2E;
constexpr float QS_WIN = 0.125f * LOG2E;
constexpr float LOG2_ROPE = 13.287712379549449f;
constexpr float RESCALE_THR = 8.0f;

__device__ __forceinline__ void rope2(float& x1, float& x2, float ang) { const float s = __sinf(ang), c = __cosf(ang);   const float a = x1 * c - x2 * s, b = x1 * s + x2 * c; x1 = a; x2 = b; }

__device__ __forceinline__ void prep1(const Args& a, const bf16* __restrict__ Z0, bf16* __restrict__ CN, bf16* __restrict__ KM, bf16* __restrict__ KW, bf16* __restrict__ VW, bf16* __restrict__ QW, int lane, int gw, int NGW) {
    const float* g_qa = a.in[12]; const float* g_kva = a.in[13]; const float* g_kr = a.in[19]; const float* g_q = a.in[20]; const float* g_k = a.in[21];
    const float inv_kr = __builtin_amdgcn_exp2f(-(float)(lane & 7) * (LOG2_ROPE / 8.0f));
    const float inv_wk = __builtin_amdgcn_exp2f(-(float)(lane & 15) * (LOG2_ROPE / 16.0f));
    float inv_wq[4];
#pragma unroll
    for (int p = 0; p < 4; ++p) inv_wq[p] = __builtin_amdgcn_exp2f(-(float)((4 * (lane & 7) + p) & 15) * (LOG2_ROPE / 16.0f));
#pragma unroll 2
    for (int r = gw; r < NTOK; r += NGW) {
        const bool isc = r >= NLAT;
        int b, n; float prow = 0.f, pcol = 0.f;
        if (!isc) { b = r >> 13; const int t = r & (SEQ - 1); n = CTXL + t; prow = (float)(t >> 6); pcol = (float)(t & 63); } else { const int rc = r - NLAT; b = rc >> 8; n = rc & 255; }
        const bf16* zr = Z0 + (size_t)r * ZW0;
        {
            const unsigned w = *(const unsigned*)(zr + 2 * lane); float x0 = bflo(w), x1 = bfhi(w);
            const float rstd = rsqrtf(wave_sum(x0 * x0 + x1 * x1) * (1.0f / 128.0f) + 1e-6f);
            *(unsigned*)(CN + (size_t)r * UPK + 2 * lane) = pk2(x0 * rstd * g_kva[2 * lane], x1 * rstd * g_kva[2 * lane + 1]);
        }
        {
            const v2u w = *(const v2u*)(zr + 416 + 4 * lane); float x0 = bflo(w.x), x1 = bfhi(w.x), x2 = bflo(w.y), x3 = bfhi(w.y);
            const float rstd = rsqrtf(wave_sum((x0 * x0 + x1 * x1) + (x2 * x2 + x3 * x3)) * (1.0f / 256.0f) + 1e-6f);
            const f32x4 g = *(const f32x4*)(g_qa + 4 * lane);
            v2u o; o.x = pk2(x0 * rstd * g.x, x1 * rstd * g.y); o.y = pk2(x2 * rstd * g.z, x3 * rstd * g.w);
            *(v2u*)(CN + (size_t)r * UPK + 128 + 4 * lane) = o;
        }
        {
            float x0 = 0.f, x1 = 0.f;
            if (lane < 16) { const unsigned w = *(const unsigned*)(zr + 128 + 2 * lane); x0 = bflo(w); x1 = bfhi(w); }
            const float rstd = rsqrtf(wave_sum(x0 * x0 + x1 * x1) * (1.0f / 32.0f) + 1e-6f);
            if (lane < 16) {
                x0 *= rstd * g_kr[2 * lane]; x1 *= rstd * g_kr[2 * lane + 1];
                if (!isc) rope2(x0, x1, (lane < 8 ? prow : pcol) * inv_kr);
                const unsigned o = pk2(x0, x1);
#pragma unroll
                for (int h = 0; h < 8; ++h) *(unsigned*)(KM + ((size_t)(b * 8 + h) * NKEY + n) * 96 + 64 + 2 * lane) = o;
            }
        }
        {
            const int hk = lane >> 5, i = lane & 31;
            const unsigned w = *(const unsigned*)(zr + 160 + 2 * lane); float x0 = bflo(w), x1 = bfhi(w);
            float ss = x0 * x0 + x1 * x1;
            ss += __shfl_xor(ss, 1); ss += __shfl_xor(ss, 2); ss += __shfl_xor(ss, 4); ss += __shfl_xor(ss, 8); ss += __shfl_xor(ss, 16);
            const float rstd = rsqrtf(ss * (1.0f / 64.0f) + 1e-6f);
            x0 *= rstd * g_k[2 * i]; x1 *= rstd * g_k[2 * i + 1];
            if (!isc) rope2(x0, x1, (i < 16 ? prow : pcol) * inv_wk);
            const size_t ko = ((size_t)(b * 2 + hk) * NKEY + n) * 64 + 2 * i;
            *(unsigned*)(KW + ko) = pk2(x0, x1);
            *(unsigned*)(VW + ko) = *(const unsigned*)(zr + 288 + 2 * lane);
        }
        {
            const int j = lane & 7;
            const v4u w = *(const v4u*)(zr + 672 + 8 * lane);
            float x[8] = {bflo(w.x), bfhi(w.x), bflo(w.y), bfhi(w.y), bflo(w.z), bfhi(w.z), bflo(w.w), bfhi(w.w)};
            float ss = 0.f;
#pragma unroll
            for (int e = 0; e < 8; ++e) ss += x[e] * x[e];
            ss += __shfl_xor(ss, 1); ss += __shfl_xor(ss, 2); ss += __shfl_xor(ss, 4);
            const float rstd = rsqrtf(ss * (1.0f / 64.0f) + 1e-6f);
            const f32x4 g0 = *(const f32x4*)(g_q + 8 * j), g1 = *(const f32x4*)(g_q + 8 * j + 4);
            const float gg[8] = {g0.x, g0.y, g0.z, g0.w, g1.x, g1.y, g1.z, g1.w};
#pragma unroll
            for (int e = 0; e < 8; ++e) x[e] *= rstd * gg[e];
            if (!isc) {
                const float pos = (j < 4) ? prow : pcol;
#pragma unroll
                for (int p = 0; p < 4; ++p) rope2(x[2 * p], x[2 * p + 1], pos * inv_wq[p]);
            }
            v4u o; o.x = pk2(x[0] * QS_WIN, x[1] * QS_WIN); o.y = pk2(x[2] * QS_WIN, x[3] * QS_WIN); o.z = pk2(x[4] * QS_WIN, x[5] * QS_WIN); o.w = pk2(x[6] * QS_WIN, x[7] * QS_WIN);
            *(v4u*)(QW + (size_t)r * 512 + 8 * lane) = o;
        }
    }
}
__device__ __forceinline__ void prep2(const Args& a, const bf16* __restrict__ KVQ, bf16* __restrict__ KM, bf16* __restrict__ VM, bf16* __restrict__ QM, int lane, int gw, int NGW) {
    const float* g_qn = a.in[16]; const float* g_qr = a.in[17]; const float* g_kn = a.in[18];
    const int hh = lane >> 3, j = lane & 7;
    float inv_qr[2];
#pragma unroll
    for (int p = 0; p < 2; ++p) inv_qr[p] = __builtin_amdgcn_exp2f(-(float)((2 * j + p) & 7) * (LOG2_ROPE / 8.0f));
#pragma unroll 2
    for (int r = gw; r < NTOK; r += NGW) {
        const bool isc = r >= NLAT;
        int b, n; float prow = 0.f, pcol = 0.f;
        if (!isc) { b = r >> 13; const int t = r & (SEQ - 1); n = CTXL + t; prow = (float)(t >> 6); pcol = (float)(t & 63); } else { const int rc = r - NLAT; b = rc >> 8; n = rc & 255; }
        const bf16* kr = KVQ + (size_t)r * UPN;
        {
            const v4u w0 = *(const v4u*)(kr + 16 * lane), w1 = *(const v4u*)(kr + 16 * lane + 8);
            const unsigned ww[8] = {w0.x, w0.y, w0.z, w0.w, w1.x, w1.y, w1.z, w1.w};
            float ss = 0.f;
#pragma unroll
            for (int e = 0; e < 8; ++e) { const float p0 = bflo(ww[e]), p1 = bfhi(ww[e]); ss += p0 * p0 + p1 * p1; }
            ss += __shfl_xor(ss, 1); ss += __shfl_xor(ss, 2);
            if (j < 4) {
                const float rstd = rsqrtf(ss * (1.0f / 64.0f) + 1e-6f);
                const float* gp = g_kn + 16 * j; unsigned o[8];
#pragma unroll
                for (int e = 0; e < 8; ++e) o[e] = pk2(bflo(ww[e]) * rstd * gp[2 * e], bfhi(ww[e]) * rstd * gp[2 * e + 1]);
                bf16* dst = KM + ((size_t)(b * 8 + hh) * NKEY + n) * 96 + 16 * j;
                *(v4u*)dst = (v4u){o[0], o[1], o[2], o[3]}; *(v4u*)(dst + 8) = (v4u){o[4], o[5], o[6], o[7]};
            } else {
                bf16* dst = VM + ((size_t)(b * 8 + hh) * NKEY + n) * 64 + 16 * (j - 4);
                *(v4u*)dst = w0; *(v4u*)(dst + 8) = w1;
            }
        }
        {
            const v4u w = *(const v4u*)(kr + 1024 + 96 * hh + 8 * j);
            float x[8] = {bflo(w.x), bfhi(w.x), bflo(w.y), bfhi(w.y), bflo(w.z), bfhi(w.z), bflo(w.w), bfhi(w.w)};
            float ss = 0.f;
#pragma unroll
            for (int e = 0; e < 8; ++e) ss += x[e] * x[e];
            ss += __shfl_xor(ss, 1); ss += __shfl_xor(ss, 2); ss += __shfl_xor(ss, 4);
            const float rstd = rsqrtf(ss * (1.0f / 64.0f) + 1e-6f) * QS_MLA;
            const f32x4 g0 = *(const f32x4*)(g_qn + 8 * j), g1 = *(const f32x4*)(g_qn + 8 * j + 4);
            v4u o; o.x = pk2(x[0] * rstd * g0.x, x[1] * rstd * g0.y); o.y = pk2(x[2] * rstd * g0.z, x[3] * rstd * g0.w);
            o.z = pk2(x[4] * rstd * g1.x, x[5] * rstd * g1.y); o.w = pk2(x[6] * rstd * g1.z, x[7] * rstd * g1.w);
            *(v4u*)(QM + (size_t)r * 768 + 96 * hh + 8 * j) = o;
        }
        {
            const v2u w = *(const v2u*)(kr + 1024 + 96 * hh + 64 + 4 * j);
            float x0 = bflo(w.x), x1 = bfhi(w.x), x2 = bflo(w.y), x3 = bfhi(w.y);
            float ss = (x0 * x0 + x1 * x1) + (x2 * x2 + x3 * x3);
            ss += __shfl_xor(ss, 1); ss += __shfl_xor(ss, 2); ss += __shfl_xor(ss, 4);
            const float rstd = rsqrtf(ss * (1.0f / 32.0f) + 1e-6f);
            const f32x4 g = *(const f32x4*)(g_qr + 4 * j);
            x0 *= rstd * g.x; x1 *= rstd * g.y; x2 *= rstd * g.z; x3 *= rstd * g.w;
            if (!isc) { const float pos = (j < 4) ? prow : pcol; rope2(x0, x1, pos * inv_qr[0]); rope2(x2, x3, pos * inv_qr[1]); }
            v2u o; o.x = pk2(x0 * QS_MLA, x1 * QS_MLA); o.y = pk2(x2 * QS_MLA, x3 * QS_MLA);
            *(v2u*)(QM + (size_t)r * 768 + 96 * hh + 64 + 4 * j) = o;
        }
    }
}

typedef float f32x2 __attribute__((ext_vector_type(2)));
__device__ __forceinline__ float max3f(float a, float b, float c) { float r; asm("v_max3_f32 %0, %1, %2, %3" : "=v"(r) : "v"(a), "v"(b), "v"(c)); return r; }
template <int DQK, bool WIN>
__device__ __forceinline__ void attn_unit(const bf16* Qp, int qld, const bf16* Kb, const bf16* Vb, bf16* Op, int ntiles, int latj0, int qlat0, float m_init, float l_init,
                                          LAS unsigned char* lds, int tid, int lane, int wave) {
    constexpr int KS = DQK + 8, VS = 68, KCH = DQK / 8;
    constexpr int KBYTES = 64 * KS * 2, VBYTES = 64 * VS * 2;
    const int l31 = lane & 31, hh = lane >> 5;
    bf16x8 qf[DQK / 16];
    { const bf16* qr = Qp + (size_t)(32 * wave + l31) * qld + 8 * hh;
#pragma unroll
      for (int ks = 0; ks < DQK / 16; ++ks) qf[ks] = *(const bf16x8*)(qr + 16 * ks); }
    f32x16 ot[2];
#pragma unroll
    for (int i = 0; i < 16; ++i) { ot[0][i] = 0.f; ot[1][i] = 0.f; }
    float m = m_init, l = l_init;
    const int kc0 = tid, kc1 = tid + 512;
    const int vkey = tid & 63, vdc = tid >> 6;
    const bool has1 = (KCH * 64 > 512) && (kc1 < KCH * 64);
    const int kg0 = (kc0 / KCH) * DQK + 8 * (kc0 % KCH), kg1 = (kc1 / KCH) * DQK + 8 * (kc1 % KCH), vg = vkey * 64 + 8 * vdc;
    const int kl0 = (kc0 / KCH) * KS + 8 * (kc0 % KCH), kl1 = (kc1 / KCH) * KS + 8 * (kc1 % KCH), vl = (8 * vdc) * VS + vkey;
    v4u kA[4], kB[4], vR[4];
#pragma unroll
    for (int i = 0; i < 4; ++i) { kA[i] = (v4u){0u, 0u, 0u, 0u}; kB[i] = kA[i]; vR[i] = kA[i]; }
#define ATT_LOAD(jj, S) do { int j_ = (jj); j_ = j_ < ntiles ? j_ : ntiles - 1; const int n0_ = j_ < 4 ? 64 * j_ : CTXL + 64 * (latj0 + j_ - 4); \
        kA[S] = *(const v4u*)(Kb + (size_t)n0_ * DQK + kg0); if (has1) kB[S] = *(const v4u*)(Kb + (size_t)n0_ * DQK + kg1); vR[S] = *(const v4u*)(Vb + (size_t)n0_ * 64 + vg); } while (0)
#define ATT_STORE(kb, vb, S) do { LAS bf16* B_ = (LAS bf16*)(lds + (kb) * KBYTES); *(LAS v4u*)(B_ + kl0) = kA[S]; if (has1) *(LAS v4u*)(B_ + kl1) = kB[S]; \
        LAS bf16* vp_ = (LAS bf16*)(lds + 4 * KBYTES + (vb) * VBYTES) + vl; const v4u vr = vR[S]; \
        vp_[0 * VS] = (bf16)(vr.x & 0xffffu); vp_[1 * VS] = (bf16)(vr.x >> 16); vp_[2 * VS] = (bf16)(vr.y & 0xffffu); vp_[3 * VS] = (bf16)(vr.y >> 16); \
        vp_[4 * VS] = (bf16)(vr.z & 0xffffu); vp_[5 * VS] = (bf16)(vr.z >> 16); vp_[6 * VS] = (bf16)(vr.w & 0xffffu); vp_[7 * VS] = (bf16)(vr.w >> 16); } while (0)
#define ATT_QK(ST, kb, cc) do { const LAS bf16* Kl_ = (const LAS bf16*)(lds + (kb) * KBYTES); const float ni_ = -(cc); \
        _Pragma("unroll") for (int kt = 0; kt < 2; ++kt) { \
            _Pragma("unroll") for (int i = 0; i < 16; ++i) ST[kt][i] = ni_; \
            _Pragma("unroll") for (int ks = 0; ks < DQK / 16; ++ks) { \
                const bf16x8 A = *(const LAS bf16x8*)(Kl_ + (32 * kt + l31) * KS + 16 * ks + 8 * hh); \
                ST[kt] = MFMA32(A, qf[ks], ST[kt]); } } } while (0)
#define ATT_DECIDE(ST, cc, mxv) do { \
        if (__any((mxv) + (cc) > m + RESCALE_THR)) { \
            const float mr_ = fmaxf((mxv), __shfl_xor((mxv), 32)); \
            const float mn = fmaxf(m, mr_ + (cc)), alpha = __builtin_amdgcn_exp2f(m - mn); \
            m = mn; l *= alpha; \
            const f32x2 a2 = {alpha, alpha}; \
            _Pragma("unroll") for (int dt = 0; dt < 2; ++dt) \
                _Pragma("unroll") for (int i = 0; i < 8; ++i) { f32x2 v = {ot[dt][2 * i], ot[dt][2 * i + 1]}; v = v * a2; ot[dt][2 * i] = v.x; ot[dt][2 * i + 1] = v.y; } \
            const float dlt = (cc) - m; const f32x2 d2 = {dlt, dlt}; \
            _Pragma("unroll") for (int kt = 0; kt < 2; ++kt) \
                _Pragma("unroll") for (int i = 0; i < 8; ++i) { f32x2 v = {ST[kt][2 * i], ST[kt][2 * i + 1]}; v = v + d2; ST[kt][2 * i] = v.x; ST[kt][2 * i + 1] = v.y; } \
            cref = m; _Pragma("unroll") for (int i = 0; i < 16; ++i) negc[i] = -m; } } while (0)
#define ATT_ITER(j, S2, CUR, NXT, BAR) do { \
        ATT_STORE(((j) + 3) & 3, vst, S2); ATT_LOAD((j) + 7, S2); \
        const float c_next = cref;     \
        f32x2 ls2 = {0.f, 0.f}; \
        unsigned pw[2][8]; \
        float mxn; \
        { constexpr int KST = DQK / 16, NS = 2 * KST; \
          const LAS bf16* Kl_ = (const LAS bf16*)(lds + (((j) + 1) & 3) * KBYTES) + l31 * KS + 8 * hh; \
          const LAS bf16* Vt_ = (const LAS bf16*)(lds + 4 * KBYTES + vrd * VBYTES) + l31 * VS + 4 * hh; \
          bf16x8 kf[NS]; s16x4 vlo[8], vhi[8]; \
          kf[0] = *(const LAS bf16x8*)(Kl_); kf[1] = *(const LAS bf16x8*)(Kl_ + 16); \
          __builtin_amdgcn_sched_barrier(0); \
          _Pragma("unroll") for (int s_ = 0; s_ < NS; ++s_) { \
              if (s_ + 2 < NS) { const int kt2 = (s_ + 2) / KST, ks2 = (s_ + 2) % KST; kf[s_ + 2] = *(const LAS bf16x8*)(Kl_ + 32 * kt2 * KS + 16 * ks2); } \
              if (s_ + 2 >= NS) { const int e = s_ + 2 - NS; vlo[e] = *(const LAS s16x4*)(Vt_ + 32 * (e & 1) * VS + 32 * (e >> 2) + 16 * ((e >> 1) & 1)); vhi[e] = *(const LAS s16x4*)(Vt_ + 32 * (e & 1) * VS + 32 * (e >> 2) + 16 * ((e >> 1) & 1) + 8); } \
              { const int kt = s_ / KST, ks = s_ % KST; NXT[kt] = (ks == 0) ? MFMA32(kf[s_], qf[ks], negc) : MFMA32(kf[s_], qf[ks], NXT[kt]); } \
              { const int np = (NS == 8 || s_ < 4) ? 2 : 1, first = (NS == 8 || s_ < 4) ? 2 * s_ : s_ + 4; \
                _Pragma("unroll") for (int q_ = 0; q_ < np; ++q_) { const int pi = first + q_, kt = pi >> 3, i = pi & 7; \
                    f32x2 p; p.x = __builtin_amdgcn_exp2f(CUR[kt][2 * i]); p.y = __builtin_amdgcn_exp2f(CUR[kt][2 * i + 1]); ls2 = ls2 + p; pw[kt][i] = pk2(p.x, p.y); } } \
              __builtin_amdgcn_sched_barrier(0); \
          } \
          const int qq_ = qlat0 + 32 * wave + l31, kbase_ = 64 * (latj0 + (j) + 1 - 4) + 4 * hh; \
          mxn = -3.0e38f; \
          __builtin_amdgcn_s_setprio(1);     \
          _Pragma("unroll") for (int e = 0; e < 8; ++e) { \
              if (e + 2 < 8) { const int e2 = e + 2; vlo[e2] = *(const LAS s16x4*)(Vt_ + 32 * (e2 & 1) * VS + 32 * (e2 >> 2) + 16 * ((e2 >> 1) & 1)); vhi[e2] = *(const LAS s16x4*)(Vt_ + 32 * (e2 & 1) * VS + 32 * (e2 >> 2) + 16 * ((e2 >> 1) & 1) + 8); } \
              const int kt = e >> 2, sI = (e >> 1) & 1, dt = e & 1; \
              const v4u pv = {pw[kt][4 * sI], pw[kt][4 * sI + 1], pw[kt][4 * sI + 2], pw[kt][4 * sI + 3]}; \
              const bf16x8 pb = __builtin_bit_cast(bf16x8, pv); \
              const bf16x8 A = __builtin_shufflevector(vlo[e], vhi[e], 0, 1, 2, 3, 4, 5, 6, 7); \
              ot[dt] = MFMA32(A, pb, ot[dt]); \
              { const int kn = e >> 2, i0 = 4 * (e & 3);     \
                if (WIN && (j) + 1 >= 4) { \
                    _Pragma("unroll") for (int i = i0; i < i0 + 4; ++i) { const int kk = kbase_ + 32 * kn + (i & 3) + 8 * (i >> 2); const int d = qq_ - kk; if (d > 128 || d < -128) NXT[kn][i] = -1e30f; } } \
                mxn = max3f(mxn, NXT[kn][i0], NXT[kn][i0 + 1]); mxn = max3f(mxn, NXT[kn][i0 + 2], NXT[kn][i0 + 3]); } \
              __builtin_amdgcn_sched_barrier(0); \
          } \
          __builtin_amdgcn_s_setprio(0); } \
        l += ls2.x + ls2.y;     \
        ATT_DECIDE(NXT, c_next, mxn); \
        vrd = vrd == 4 ? 0 : vrd + 1; vst = vst == 4 ? 0 : vst + 1; \
        if (BAR) __syncthreads(); } while (0)
    ATT_LOAD(0, 0); ATT_LOAD(1, 1); ATT_LOAD(2, 2); ATT_LOAD(3, 3);
    ATT_STORE(0, 0, 0); ATT_STORE(1, 1, 1); ATT_STORE(2, 2, 2);
    ATT_LOAD(4, 0); ATT_LOAD(5, 1); ATT_LOAD(6, 2);
    __syncthreads();
    const float c0_ = m < -1e29f ? 0.f : m;
    float cref = c0_; f32x16 negc;
#pragma unroll
    for (int i = 0; i < 16; ++i) negc[i] = -c0_;
    int vrd = 0, vst = 3;
    f32x16 stA[2], stB[2];
    ATT_QK(stA, 0, c0_);
    { float mx0 = max3f(stA[0][0], stA[0][1], stA[1][0]);
#pragma unroll
      for (int i = 1; i < 8; ++i) mx0 = max3f(mx0, stA[0][2 * i], stA[0][2 * i + 1]);
#pragma unroll
      for (int i = 1; i < 8; ++i) mx0 = max3f(mx0, stA[1][2 * i], stA[1][2 * i + 1]);
      mx0 = fmaxf(mx0, stA[1][1]);
      ATT_DECIDE(stA, c0_, mx0); }
    __syncthreads();
#pragma unroll 1
    for (int j = 0; j < ntiles; j += 4) {
        ATT_ITER(j, 3, stA, stB, false);
        if (j + 1 < ntiles) ATT_ITER(j + 1, 0, stB, stA, true);
        if (j + 2 < ntiles) ATT_ITER(j + 2, 1, stA, stB, false);
        if (j + 3 < ntiles) ATT_ITER(j + 3, 2, stB, stA, true);
    }
#undef ATT_ITER
#undef ATT_DECIDE
#undef ATT_QK
#undef ATT_LOAD
#undef ATT_STORE
    l += __shfl_xor(l, 32);
    const float rl = 1.0f / l;
    bf16* orow = Op + (size_t)(32 * wave + l31) * DM + 4 * hh;
#pragma unroll
    for (int dt = 0; dt < 2; ++dt)
#pragma unroll
        for (int g = 0; g < 4; ++g) { v2u w; w.x = pk2(ot[dt][4 * g] * rl, ot[dt][4 * g + 1] * rl); w.y = pk2(ot[dt][4 * g + 2] * rl, ot[dt][4 * g + 3] * rl);
            *(v2u*)(orow + 32 * dt + 8 * g) = w; }
}

__device__ __forceinline__ void attn_phase(const Args& a, const bf16* QM, const bf16* KM, const bf16* VM, const bf16* QW, const bf16* KW, const bf16* VW, bf16* O,
                                           LAS unsigned char* lds, int tid, int lane_unused, int wave_unused, int G) {
    const float* sink = a.in[22];
    const int tid0_ = tid;
    for (int u = blockIdx.x; u < 4224; u += G) {
        int tid = tid0_; asm volatile("" : "+v"(tid));
        const int lane = tid & 63; const int wave = __builtin_amdgcn_readfirstlane(tid >> 6);
        if (u < 4096) {
            const int v = u & 2047; const int bh = (v & 7) + 8 * (v >> 8), qb = (v >> 3) & 31; const int b = bh >> 3, h = bh & 7;
            const int row0 = b * SEQ + 256 * qb;
            if (u < 2048) {
                attn_unit<96, false>(QM + (size_t)row0 * 768 + 96 * h, 768, KM + (size_t)bh * NKEY * 96, VM + (size_t)bh * NKEY * 64, O + (size_t)row0 * DM + 64 * h,
                                     132, 0, 0, -1e30f, 0.f, lds, tid, lane, wave);
            } else {
                const int hk = h >> 2; const int j0 = (4 * qb - 2) > 0 ? (4 * qb - 2) : 0, j1 = (4 * qb + 5) < 127 ? (4 * qb + 5) : 127;
                attn_unit<64, true>(QW + (size_t)row0 * 512 + 64 * h, 512, KW + (size_t)(b * 2 + hk) * NKEY * 64, VW + (size_t)(b * 2 + hk) * NKEY * 64, O + (size_t)row0 * DM + 512 + 64 * h,
                                    4 + (j1 - j0 + 1), j0, 256 * qb, sink[h] * LOG2E, 1.f, lds, tid, lane, wave);
            }
        } else {
            const int v = (u - 4096) & 63; const int b = v >> 3, h = v & 7; const int row0 = NLAT + b * CTXL;
            if (u < 4160) {
                attn_unit<96, false>(QM + (size_t)row0 * 768 + 96 * h, 768, KM + (size_t)(b * 8 + h) * NKEY * 96, VM + (size_t)(b * 8 + h) * NKEY * 64, O + (size_t)row0 * DM + 64 * h,
                                     4, 0, 0, -1e30f, 0.f, lds, tid, lane, wave);
            } else {
                const int hk = h >> 2;
                attn_unit<64, true>(QW + (size_t)row0 * 512 + 64 * h, 512, KW + (size_t)(b * 2 + hk) * NKEY * 64, VW + (size_t)(b * 2 + hk) * NKEY * 64, O + (size_t)row0 * DM + 512 + 64 * h,
                                     4, 0, 0, sink[h] * LOG2E, 1.f, lds, tid, lane, wave);
            }
        }
        __syncthreads();
    }
}
#define MIXER_L1 \
    if (l == 1) { \
        bf16* Z1 = (bf16*)(ws + O_Z1); bf16* OB = (bf16*)(ws + O_OB); \
        PH_BEGIN phase_norm(XL, XC, NTOK, ng + DM, modl, 1, H, lane, gw, NGW); PH_END \
        PROBE_ELT_X(PH_BEGIN phase_norm(XL, XC, NTOK, ng + DM, modl, 1, H, lane, gw, NGW); PH_END) \
        GEMM_PH(pg8::EpiBf16P<1>, H, (const bf16*)(ws + O_IN1), NTOK, ZW1, DM, Z1, ZW1, a.in[33], a.in[35], 0.08838834764831845f) \
        PH_BEGIN gla_scan(Z1, H, OB, lds, tid, lane, wave, G); PH_END \
        PROBE_GLA_X(PH_BEGIN gla_scan(Z1, H, OB, lds, tid, lane, wave, G); PH_END) \
        PH_BEGIN gla_combine(H, OB, Z1, a.in[36], lane, gw, NGW); PH_END \
        GEMM_PH(pg8::EpiResid, H, (const bf16*)(ws + O_OUT1), NLAT, DM, DM, XL, XC, XL, XC, modl + 5 * DM, 1.0f) \
    }
#define MIXER_L0 \
    if (l == 0) { \
        bf16* Z0 = (bf16*)(ws + O_Z0); bf16* CN = (bf16*)(ws + O_CN); bf16* QM = (bf16*)(ws + O_QM); bf16* KM = (bf16*)(ws + O_KM); bf16* VM = (bf16*)(ws + O_VM); \
        bf16* KW = (bf16*)(ws + O_KW); bf16* VW = (bf16*)(ws + O_VW); bf16* QW = (bf16*)(ws + O_QW); \
        PH_BEGIN phase_norm(XL, XC, NTOK, ng + DM, modl, 1, H, lane, gw, NGW); PH_END \
        PROBE_ELT_X(PH_BEGIN phase_norm(XL, XC, NTOK, ng + DM, modl, 1, H, lane, gw, NGW); PH_END) \
        GEMM_PH(pg8::EpiBf16P<0>, H, (const bf16*)(ws + O_IN0), NTOK, ZW0, DM, Z0, ZW0, nullptr, nullptr, 1.0f) \
        PH_BEGIN prep1(a, Z0, CN, KM, KW, VW, QW, lane, gw, NGW); PH_END \
        PROBE_ELT_X(PH_BEGIN prep1(a, Z0, CN, KM, KW, VW, QW, lane, gw, NGW); PH_END) \
        GEMM_PH(pg8::EpiBf16P<0>, CN, (const bf16*)(ws + O_UP), NTOK, UPN, UPK, Z0, UPN, nullptr, nullptr, 1.0f) \
        PH_BEGIN prep2(a, Z0, KM, VM, QM, lane, gw, NGW); PH_END \
        PROBE_ELT_X(PH_BEGIN prep2(a, Z0, KM, VM, QM, lane, gw, NGW); PH_END) \
        PH_BEGIN attn_phase(a, QM, KM, VM, QW, KW, VW, H, lds, tid, lane, wave, G); PH_END \
        PROBE_ATT_X(PH_BEGIN attn_phase(a, QM, KM, VM, QW, KW, VW, H, lds, tid, lane, wave, G); PH_END) \
        GEMM_PH(pg8::EpiResid, H, (const bf16*)(ws + O_OUT0), NTOK, DM, DM, XL, XC, XL, XC, modl + 5 * DM, 1.0f) \
    }
#define MIXER_HOOK MIXER_L0 MIXER_L1


#ifdef PROBE_GU
#define PROBE_GU_X(...) __VA_ARGS__
#else
#define PROBE_GU_X(...)
#endif
#ifdef PROBE_ATT
#define PROBE_ATT_X(...) __VA_ARGS__
#else
#define PROBE_ATT_X(...)
#endif
#ifdef PROBE_GLA
#define PROBE_GLA_X(...) __VA_ARGS__
#else
#define PROBE_GLA_X(...)
#endif
#ifdef PROBE_ELT
#define PROBE_ELT_X(...) __VA_ARGS__
#else
#define PROBE_ELT_X(...)
#endif
#ifdef PROBE_P0
#define PROBE_P0_X(...) __VA_ARGS__
#else
#define PROBE_P0_X(...)
#endif
#define PH_BEGIN { int tid = (int)threadIdx.x; asm volatile("" : "+v"(tid)); const int lane = tid & 63; const int wave = __builtin_amdgcn_readfirstlane(tid >> 6); const int gw = blockIdx.x * NWAVES + wave; (void)lane; (void)gw; (void)wave;
#define PH_END } { XcdBarrier b_; b_.bar = (unsigned*)a.ws; b_.x = xb_xcc_id(); b_.st = (volatile LAS unsigned*)(lds + 131072 + 320) + 8; xcd_barrier(b_); }
#define GEMM_PH(EPI, Aptr, Bptr, Mrows, Ncols, Kdim, ...) PH_BEGIN { int kx_ = (Kdim); asm volatile("" : "+s"(kx_)); pg8::Gemm g{(Aptr), (Bptr), (Mrows), (Ncols), kx_}; pg8::StaticOrder S; S.init((Mrows), (Ncols), G, (int)blockIdx.x); \
    EPI E{__VA_ARGS__}; pg8::gemm_phase<EPI, pg8::StaticOrder, true, true>(lds, g, S, E, tid); } PH_END

__global__ void __launch_bounds__(NTHR, 2) mega(Args a) {
    extern __shared__ __attribute__((aligned(16))) unsigned char lds_[];
    cg::grid_group grid = cg::this_grid();
    LAS unsigned char* lds = (LAS unsigned char*)lds_;
    const int G = gridDim.x, NGW = G * NWAVES;
    unsigned char* ws = a.ws;
    float* XL = a.out; float* XC = (float*)(ws + O_XC);
    bf16* H = (bf16*)(ws + O_H); bf16* HID = (bf16*)(ws + O_HID);
    const float* MOD = (const float*)(ws + O_MOD);

    { volatile LAS unsigned* misc = (volatile LAS unsigned*)(lds + 131072 + 320); if (threadIdx.x < 32) misc[threadIdx.x] = 0u; }
    __syncthreads();
    (void)xcd_barrier_post((unsigned*)ws, (volatile LAS unsigned*)(lds + 131072 + 320) + 8);
    if (gridDim.x == 0x7fffffffu) grid.sync();
    PH_BEGIN phase0(a, lds, tid, lane, wave, G); PH_END
    PROBE_P0_X(PH_BEGIN phase0(a, lds, tid, lane, wave, G); PH_END)
    PH_BEGIN phase_modreduce(a, tid, G); PH_END
#ifdef PROBE_SYNC
    for (int i_ = 0; i_ < 40; ++i_) { PH_BEGIN PH_END }
#endif

#pragma unroll 1
    for (int l = 0; l < 2; ++l) {
        const float* modl = MOD + (size_t)l * 9 * 9216;
        const float* ng = a.in[l == 0 ? 4 : 24];
#pragma unroll 1
        for (int f = 0; f < 2; ++f) {
            const int sub = 2 * f;
            const int nrows = (l == 1 && f == 1) ? NLAT : NTOK;
            const float* xil = (l == 0 && f == 0) ? a.in[0] : XL; const float* xic = (l == 0 && f == 0) ? a.in[2] : XC;
            PH_BEGIN phase_norm(xil, xic, nrows, ng + sub * DM, modl, sub, H, lane, gw, NGW); PH_END
            PROBE_ELT_X(PH_BEGIN phase_norm(xil, xic, nrows, ng + sub * DM, modl, sub, H, lane, gw, NGW); PH_END)
            GEMM_PH(pg8::EpiSwiglu, H, (const bf16*)(ws + (l == 0 ? (f == 0 ? O_GU0A : O_GU0B) : (f == 0 ? O_GU1A : O_GU1B))), nrows, 2 * DFF, DM, HID, DFF)
            PROBE_GU_X(GEMM_PH(pg8::EpiSwiglu, H, (const bf16*)(ws + (l == 0 ? (f == 0 ? O_GU0A : O_GU0B) : (f == 0 ? O_GU1A : O_GU1B))), nrows, 2 * DFF, DM, HID, DFF))
            GEMM_PH(pg8::EpiResid, HID, (const bf16*)(ws + (l == 0 ? (f == 0 ? O_DN0A : O_DN0B) : (f == 0 ? O_DN1A : O_DN1B))), nrows, DM, DFF, xil, xic, XL, XC, modl + (3 * sub + 2) * DM, 0.5f)
            if (f == 0) {
                MIXER_HOOK
            }
        }
    }
}

extern "C" void kernel_launch(void* const* d_in, const int* in_sizes, int n_in, void* d_out, int out_size, void* d_ws, size_t ws_size, hipStream_t stream) {
    static int grid = 0;
    if (grid == 0) {
        int dev = 0, cus = 0, per_cu = 0;
        if (n_in != 38 || ws_size < WS_NEED) { fprintf(stderr, "kernel_launch: n_in %d ws %zu need %zu\n", n_in, ws_size, (size_t)WS_NEED); grid = -1; return; }
        if (hipGetDevice(&dev) != hipSuccess || hipDeviceGetAttribute(&cus, hipDeviceAttributeMultiprocessorCount, dev) != hipSuccess) { grid = -1; return; }
        if (hipFuncSetAttribute((const void*)mega, hipFuncAttributeMaxDynamicSharedMemorySize, LDS_BYTES) != hipSuccess) { fprintf(stderr, "kernel_launch: hipFuncSetAttribute failed\n"); grid = -1; return; }
        if (hipOccupancyMaxActiveBlocksPerMultiprocessor(&per_cu, (const void*)mega, NTHR, LDS_BYTES) != hipSuccess || per_cu < 1) { fprintf(stderr, "kernel_launch: occupancy query %d\n", per_cu); per_cu = 1; (void)hipGetLastError(); }
        grid = cus * per_cu;
    }
    if (grid < 0) return;
    if (hipMemsetAsync(d_ws, 0, 16384, stream) != hipSuccess)     { fprintf(stderr, "kernel_launch: memset failed\n"); return; }
    Args a{};
    for (int i = 0; i < 38; ++i) a.in[i] = (const float*)d_in[i];
    a.out = (float*)d_out; a.ws = (unsigned char*)d_ws;
    void* args[] = {&a};
    hipError_t e = hipLaunchCooperativeKernel((void*)mega, dim3(grid), dim3(NTHR), args, LDS_BYTES, stream);
    if (e != hipSuccess) fprintf(stderr, "cooperative launch failed: %s (grid %d)\n", hipGetErrorString(e), grid);
}
```

```cpp
#include <hip/hip_runtime.h>
#include <hip/hip_cooperative_groups.h>
#include <cstdio>
#include <cstdint>
namespace cg = cooperative_groups;
namespace pg8 {
#define PG8_LAS __attribute__((address_space(3)))
typedef unsigned short bf16_t;
typedef short bf16x8 __attribute__((ext_vector_type(8)));
typedef float f32x4 __attribute__((ext_vector_type(4)));
typedef unsigned u32x4 __attribute__((ext_vector_type(4)));
constexpr int BM = 256, BK = 64, HALF = 128, HTB = HALF * BK * 2  , STAGE_BYTES = 8 * HTB, NXCD = 8, WGM = 8;

__host__ __device__ __forceinline__ int lds_byte(int r, int c) { const int st = (r >> 4) * 2 + (c >> 5), rr = r & 15, cc = c & 31, ob = rr * 64 + cc * 2; return st * 1024 + (ob ^ (((ob >> 9) & 1) << 5)); }
__host__ __device__ __forceinline__ void stage_rc(int b, int& R, int& C) { const int st = b / 1024, sb = b % 1024, swz = sb ^ (((sb >> 9) & 1) << 5); R = (st >> 1) * 16 + swz / 64; C = (st & 1) * 32 + (swz % 64) / 2; }
__host__ __device__ __forceinline__ int perm32(int rho) { const int n = rho >> 4, i = rho & 15; return 8 * (i >> 2) + 4 * n + (i & 3); }

struct Unit { int pm, pn; };
struct Gemm { const bf16_t* A; const bf16_t* Bt; int M, N, K; };

struct StaticOrder {
    int nM, nN, nwg, G, c;
    __host__ __device__ void init(int M, int N, int G_, int c_) { nM = M / BM; nN = N / BM; nwg = nM * nN; G = G_; c = c_; }
    __host__ __device__ bool next(int i, Unit& u) const {
        const long L = (long)i * G + c; if (L >= nwg) return false;
        int wgid = (int)L; { const int q = nwg / NXCD, r = nwg % NXCD, xcd = wgid % NXCD, off = wgid / NXCD; wgid = (xcd < r ? xcd * (q + 1) : r * (q + 1) + (xcd - r) * q) + off; }
        const int nig = WGM * nN, gid = wgid / nig, fm = gid * WGM, gsz = (nM - fm) < WGM ? (nM - fm) : WGM;
        u.pm = fm + ((wgid % nig) % gsz); u.pn = (wgid % nig) / gsz; return true;
    }
    __device__ __forceinline__ void a_ready(const Unit&) const {}
    __device__ __forceinline__ void done(const Unit&) const {}
};

__device__ __forceinline__ unsigned f2bf_(float f) { unsigned u = __builtin_bit_cast(unsigned, f); return (u + 0x7fffu + ((u >> 16) & 1u)) >> 16; }
typedef __bf16 bf16v2_e __attribute__((ext_vector_type(2)));
typedef float f32x2_e __attribute__((ext_vector_type(2)));
__device__ __forceinline__ unsigned pk2_(float lo, float hi) { return __builtin_bit_cast(unsigned, __builtin_convertvector((f32x2_e){lo, hi}, bf16v2_e)); }
__device__ __forceinline__ float silu_(float x) { return x * __builtin_amdgcn_rcpf(1.0f + __builtin_amdgcn_exp2f(-1.4426950408889634f * x)); }
constexpr float GATE_SC = 0.0625f * 1.4426950408889634f;
__device__ __forceinline__ float logsig_(float z) { return fminf(z, 0.f) - __logf(1.0f + __expf(-fabsf(z))); }

struct EpiSwiglu {
    static constexpr bool PERM = true, AFTER_DRAIN = false;
    bf16_t* O; int ldc;
    __device__ __forceinline__ void operator()(const f32x4 (&acc)[2][2][4][2], const Unit& u, int wr, int wc, int fr, int fq) const {
        const int row0 = u.pm * BM + wr * 64 + fr, col0 = u.pn * HALF + wc * 32 + 8 * fq;
#pragma unroll
        for (int ai = 0; ai < 2; ++ai)
#pragma unroll
            for (int m = 0; m < 4; ++m) {
                bf16_t* p = O + (size_t)(row0 + ai * HALF + m * 16) * ldc + col0;
                const f32x4 g0 = acc[ai][0][m][0], g1 = acc[ai][0][m][1], u0 = acc[ai][1][m][0], u1 = acc[ai][1][m][1];
                u32x4 w;
                w.x = pk2_(silu_(g0[0]) * u0[0], silu_(g0[1]) * u0[1]); w.y = pk2_(silu_(g0[2]) * u0[2], silu_(g0[3]) * u0[3]);
                w.z = pk2_(silu_(g1[0]) * u1[0], silu_(g1[1]) * u1[1]); w.w = pk2_(silu_(g1[2]) * u1[2], silu_(g1[3]) * u1[3]);
                *(u32x4*)p = w;
            }
    }
};
struct EpiResid {
    static constexpr bool PERM = false, AFTER_DRAIN = false;
    const float* xin_l; const float* xin_c; float* xout_l; float* xout_c; const float* gate; float coef;
    __device__ __forceinline__ void operator()(const f32x4 (&acc)[2][2][4][2], const Unit& u, int wr, int wc, int fr, int fq) const {
        const int rowbase = u.pm * BM; const bool isc = rowbase >= 65536; const int b = isc ? 8 : (rowbase >> 13);
        const float* xi = isc ? xin_c : xin_l; float* xo = isc ? xout_c : xout_l;
        const int lrow0 = (isc ? rowbase - 65536 : rowbase) + wr * 64 + fr; const int col0 = u.pn * BM + wc * 32 + 4 * fq;
        const float* gp = gate + (size_t)b * 9216 + col0;
#pragma unroll
        for (int bj = 0; bj < 2; ++bj)
#pragma unroll
            for (int n = 0; n < 2; ++n) {
                const f32x4 gv = *(const f32x4*)(gp + bj * HALF + n * 16) * coef;
#pragma unroll
                for (int ai = 0; ai < 2; ++ai)
#pragma unroll
                    for (int m = 0; m < 4; ++m) {
                        const size_t off = (size_t)(lrow0 + ai * HALF + m * 16) * 1024 + col0 + bj * HALF + n * 16;
                        const f32x4 xv = *(const f32x4*)(xi + off);
                        *(f32x4*)(xo + off) = xv + gv * acc[ai][bj][m][n];
                    }
            }
    }
};
template <int MODE> struct EpiBf16P {
    static constexpr bool PERM = true, AFTER_DRAIN = false;
    bf16_t* O; int ldc; const float* bias_f; const float* bias_b; float qscale;
    __device__ __forceinline__ void operator()(const f32x4 (&acc)[2][2][4][2], const Unit& u, int wr, int wc, int fr, int fq) const {
        const int row0 = u.pm * BM + wr * 64 + fr, col0 = u.pn * BM + wc * 32 + 8 * fq;
        int mode = 0; const float* bp = bias_f;
        if (MODE == 1) { if (u.pn >= 6 && u.pn < 10) { mode = 1; bp = (u.pn < 8) ? (bias_f + (col0 - 1536)) : (bias_b + (col0 - 2048)); } else if (u.pn >= 10 && u.pn < 12) mode = 2; }
#pragma unroll
        for (int bj = 0; bj < 2; ++bj) {
            f32x4 b0 = (f32x4){0.f, 0.f, 0.f, 0.f}, b1 = b0;
            if (MODE == 1 && mode == 1) { b0 = *(const f32x4*)(bp + bj * HALF); b1 = *(const f32x4*)(bp + bj * HALF + 4); }
#pragma unroll
            for (int ai = 0; ai < 2; ++ai)
#pragma unroll
                for (int m = 0; m < 4; ++m) {
                    f32x4 v0 = acc[ai][bj][m][0], v1 = acc[ai][bj][m][1];
                    if (MODE == 1) {
                        if (mode == 1) {
                            v0 = v0 + b0; v1 = v1 + b1;
#pragma unroll
                            for (int e = 0; e < 4; ++e) { v0[e] = logsig_(v0[e]) * GATE_SC; v1[e] = logsig_(v1[e]) * GATE_SC; }
                        } else if (mode == 2) { v0 = v0 * qscale; v1 = v1 * qscale; }
                    }
                    u32x4 w; w.x = pk2_(v0[0], v0[1]); w.y = pk2_(v0[2], v0[3]); w.z = pk2_(v1[0], v1[1]); w.w = pk2_(v1[2], v1[3]);
                    *(u32x4*)(O + (size_t)(row0 + ai * HALF + m * 16) * ldc + col0 + bj * HALF) = w;
                }
        }
    }
};
template <class Epi, class Sched, bool ALIGN_EPI = false, bool SP2 = false>
__device__ __forceinline__ void gemm_phase(PG8_LAS unsigned char* lds, const Gemm g, const Sched& S, const Epi& E, int tid_in) {
    const int tid = tid_in, wid = __builtin_amdgcn_readfirstlane(tid >> 6), lane = tid & 63, wr = wid >> 2, wc = wid & 3, fr = lane & 15, fq = lane >> 4;
    const int K = g.K, nt = K / BK;
    unsigned voffA[2], voffB[2];
#pragma unroll
    for (int i = 0; i < 2; ++i) { int R, C; stage_rc(tid * 16 + i * 8192, R, C); const int Rb = Epi::PERM ? ((R & ~31) + perm32(R & 31)) : R;
        voffA[i] = (unsigned)(R * K + C) * 2u; voffB[i] = (unsigned)(Rb * K + C) * 2u; }
    const size_t kstep = (size_t)(BK * 2);
    const size_t hstep = (size_t)HALF * K * 2;
    const size_t tstep = 2 * hstep;
    const unsigned ldsw = (unsigned)wid * 1024u;
    const int aoff = lds_byte(wr * 64 + fr, fq * 8), boff = lds_byte(wc * 32 + fr, fq * 8);
#define PG8_SA(b, h) (((b) * 2 + (h)) * HTB)
#define PG8_SB(b, h) ((4 + (b) * 2 + (h)) * HTB)
#define PG8_STAGE(bufoff, gbase, voff) do { _Pragma("unroll") for (int _i = 0; _i < 2; ++_i) \
        __builtin_amdgcn_global_load_lds((const unsigned*)((const char*)(gbase) + (voff)[_i]), (PG8_LAS unsigned*)(lds + (bufoff) + ldsw + _i * 8192), 16, 0, 0); } while (0)
#define PG8_LDA(dst, b, h) do { _Pragma("unroll") for (int m = 0; m < 4; ++m) _Pragma("unroll") for (int k = 0; k < 2; ++k) dst[m][k] = *(const PG8_LAS bf16x8*)(lds + PG8_SA(b, h) + aoff + m * 2048 + k * 1024); } while (0)
#define PG8_LDB(dst, b, h) do { _Pragma("unroll") for (int n = 0; n < 2; ++n) _Pragma("unroll") for (int k = 0; k < 2; ++k) dst[n][k] = *(const PG8_LAS bf16x8*)(lds + PG8_SB(b, h) + boff + n * 2048 + k * 1024); } while (0)
#define PG8_MMA(ai, bj, At, Bt) do { __builtin_amdgcn_s_setprio(1); _Pragma("unroll") for (int m = 0; m < 4; ++m) _Pragma("unroll") for (int n = 0; n < 2; ++n) _Pragma("unroll") for (int k = 0; k < 2; ++k) \
        acc[ai][bj][m][n] = __builtin_amdgcn_mfma_f32_16x16x32_bf16(Bt[n][k], At[m][k], acc[ai][bj][m][n], 0, 0, 0); __builtin_amdgcn_s_setprio(0); } while (0)
#define PG8_WAIT_V(n) asm volatile("s_waitcnt vmcnt(" #n ")" ::: "memory")
#define PG8_WAIT_L(n) asm volatile("s_waitcnt lgkmcnt(" #n ")" ::: "memory")
#define PG8_BAR __builtin_amdgcn_s_barrier()
#define PG8_SCHED __builtin_amdgcn_sched_barrier(0)
    Unit cur, nxt; int ui = 0;
    if (!S.next(0, cur)) return;
    f32x4 acc[2][2][4][2];
#pragma unroll
    for (int a = 0; a < 2; ++a)
#pragma unroll
        for (int b = 0; b < 2; ++b)
#pragma unroll
            for (int m = 0; m < 4; ++m)
#pragma unroll
                for (int n = 0; n < 2; ++n) acc[a][b][m][n] = (f32x4){0.f, 0.f, 0.f, 0.f};
    bf16x8 At[4][2], B0[2][2], B1[2][2];
    const char* cA = (const char*)g.A + (size_t)cur.pm * tstep; const char* cB = (const char*)g.Bt + (size_t)cur.pn * tstep;
    S.a_ready(cur);
    if constexpr (SP2) {
        PG8_STAGE(PG8_SB(0, 0), cB, voffB); PG8_STAGE(PG8_SB(0, 1), cB + hstep, voffB); PG8_STAGE(PG8_SA(0, 0), cA, voffA); PG8_STAGE(PG8_SA(0, 1), cA + hstep, voffA);
        if (wr == 1) PG8_BAR;
        PG8_WAIT_V(2); PG8_BAR;
        PG8_STAGE(PG8_SB(1, 0), cB + kstep, voffB); PG8_STAGE(PG8_SA(1, 0), cA + kstep, voffA); PG8_STAGE(PG8_SB(1, 1), cB + hstep + kstep, voffB);
        PG8_WAIT_V(6); PG8_BAR;
    } else {
        PG8_STAGE(PG8_SB(0, 0), cB, voffB); PG8_STAGE(PG8_SA(0, 0), cA, voffA); PG8_STAGE(PG8_SB(0, 1), cB + hstep, voffB); PG8_STAGE(PG8_SA(0, 1), cA + hstep, voffA);
        if (wr == 1) PG8_BAR;
        PG8_WAIT_V(4); PG8_BAR;
        PG8_STAGE(PG8_SB(1, 0), cB + kstep, voffB); PG8_STAGE(PG8_SA(1, 0), cA + kstep, voffA); PG8_STAGE(PG8_SB(1, 1), cB + hstep + kstep, voffB);
        PG8_WAIT_V(6); PG8_BAR;
    }
    for (;;) {
        const bool has_next = S.next(ui + 1, nxt);
        const char* nA = has_next ? (const char*)g.A + (size_t)nxt.pm * tstep : cA; const char* nB = has_next ? (const char*)g.Bt + (size_t)nxt.pn * tstep : cB;
        for (int t = 0; t < nt; t += 2) {
            const bool last = (t == nt - 2);
            const char* a1 = cA + (size_t)(t + 1) * kstep;
            const char* a2 = last ? nA : cA + (size_t)(t + 2) * kstep; const char* b2 = last ? nB : cB + (size_t)(t + 2) * kstep;
            const char* a3 = a2 + kstep; const char* b3 = b2 + kstep;
            if (last && has_next) S.a_ready(nxt);
            if constexpr (SP2) {
            PG8_LDB(B0, 0, 0); PG8_LDB(B1, 0, 1); PG8_SCHED; PG8_LDA(At, 0, 0); PG8_STAGE(PG8_SA(1, 1), a1 + hstep, voffA);
            PG8_WAIT_V(8); PG8_WAIT_L(0); PG8_BAR; PG8_MMA(0, 0, At, B0); PG8_MMA(0, 1, At, B1); PG8_BAR; PG8_SCHED;
            PG8_LDA(At, 0, 1); PG8_STAGE(PG8_SB(0, 0), b2, voffB); PG8_STAGE(PG8_SB(0, 1), b2 + hstep, voffB); PG8_STAGE(PG8_SA(0, 0), a2, voffA);
            PG8_WAIT_V(8); PG8_WAIT_L(0); PG8_BAR; PG8_MMA(1, 0, At, B0); PG8_MMA(1, 1, At, B1); PG8_BAR; PG8_SCHED;
            PG8_LDB(B0, 1, 0); PG8_LDB(B1, 1, 1); PG8_SCHED; PG8_LDA(At, 1, 0); PG8_STAGE(PG8_SA(0, 1), a2 + hstep, voffA);
            PG8_WAIT_V(8); PG8_WAIT_L(0); PG8_BAR; PG8_MMA(0, 0, At, B0); PG8_MMA(0, 1, At, B1); PG8_BAR; PG8_SCHED;
            PG8_LDA(At, 1, 1); PG8_STAGE(PG8_SB(1, 0), b3, voffB); PG8_STAGE(PG8_SB(1, 1), b3 + hstep, voffB); PG8_STAGE(PG8_SA(1, 0), a3, voffA);
            PG8_WAIT_V(8); PG8_WAIT_L(0); PG8_BAR; PG8_MMA(1, 0, At, B0); PG8_MMA(1, 1, At, B1); PG8_BAR; PG8_SCHED;
            } else {
            PG8_LDB(B0, 0, 0); PG8_SCHED; PG8_LDA(At, 0, 0); PG8_STAGE(PG8_SA(1, 1), a1 + hstep, voffA);
            PG8_WAIT_L(8); PG8_BAR; PG8_WAIT_L(0); PG8_MMA(0, 0, At, B0); PG8_BAR; PG8_SCHED;
            PG8_LDB(B1, 0, 1); PG8_STAGE(PG8_SB(0, 0), b2, voffB);
            PG8_BAR; PG8_WAIT_L(0); PG8_MMA(0, 1, At, B1); PG8_BAR;
            PG8_LDA(At, 0, 1); PG8_STAGE(PG8_SA(0, 0), a2, voffA);
            PG8_BAR; PG8_WAIT_L(0); PG8_MMA(1, 0, At, B0); PG8_BAR; PG8_SCHED;
            PG8_STAGE(PG8_SB(0, 1), b2 + hstep, voffB);
            PG8_WAIT_V(6); PG8_BAR; PG8_MMA(1, 1, At, B1); PG8_BAR;
            PG8_LDB(B0, 1, 0); PG8_SCHED; PG8_LDA(At, 1, 0); PG8_STAGE(PG8_SA(0, 1), a2 + hstep, voffA);
            PG8_WAIT_L(8); PG8_BAR; PG8_WAIT_L(0); PG8_MMA(0, 0, At, B0); PG8_BAR; PG8_SCHED;
            PG8_LDB(B1, 1, 1); PG8_STAGE(PG8_SB(1, 0), b3, voffB);
            PG8_BAR; PG8_WAIT_L(0); PG8_MMA(0, 1, At, B1); PG8_BAR;
            PG8_LDA(At, 1, 1); PG8_STAGE(PG8_SA(1, 0), a3, voffA);
            PG8_BAR; PG8_WAIT_L(0); PG8_MMA(1, 0, At, B0); PG8_BAR; PG8_SCHED;
            PG8_STAGE(PG8_SB(1, 1), b3 + hstep, voffB);
            PG8_WAIT_V(6); PG8_BAR; PG8_MMA(1, 1, At, B1); PG8_BAR;
            }
        }
        if constexpr (ALIGN_EPI) { if (wr == 0) PG8_BAR; }
        if constexpr (!Epi::AFTER_DRAIN) { E(acc, cur, wr, wc, fr, fq); S.done(cur); }
        if (!has_next) break;
#pragma unroll
        for (int a = 0; a < 2; ++a)
#pragma unroll
            for (int b = 0; b < 2; ++b)
#pragma unroll
                for (int m = 0; m < 4; ++m)
#pragma unroll
                    for (int n = 0; n < 2; ++n) acc[a][b][m][n] = (f32x4){0.f, 0.f, 0.f, 0.f};
        cur = nxt; cA = nA; cB = nB; ++ui;
        if constexpr (ALIGN_EPI) { if (wr == 1) PG8_BAR; }
    }
    PG8_WAIT_V(0);
    if constexpr (!ALIGN_EPI) { if (wr == 0) PG8_BAR; }
    PG8_BAR;
    if constexpr (Epi::AFTER_DRAIN) { E.fused(acc, cur, wr, wc, fr, fq, lds, wid, lane); S.done(cur); }
#undef PG8_SA
#undef PG8_SB
#undef PG8_STAGE
#undef PG8_LDA
#undef PG8_LDB
#undef PG8_MMA
#undef PG8_WAIT_V
#undef PG8_WAIT_L
#undef PG8_BAR
#undef PG8_SCHED
}
}

#define LAS __attribute__((address_space(3)))
typedef unsigned short bf16;
typedef unsigned v4u __attribute__((ext_vector_type(4)));
typedef unsigned v2u __attribute__((ext_vector_type(2)));
typedef float f32x4 __attribute__((ext_vector_type(4)));
typedef float f32x16 __attribute__((ext_vector_type(16)));
typedef short bf16x8 __attribute__((ext_vector_type(8)));
typedef short s16x4 __attribute__((ext_vector_type(4)));

constexpr int NWAVES = 8, NTHR = 512;
constexpr int NLAT = 65536, NCTX = 2048, NTOK = NLAT + NCTX, DM = 1024, DFF = 2816, SEQ = 8192, CTXL = 256, NKEY = SEQ + CTXL;
constexpr int LDS_BYTES = 147456;
constexpr int ZW0 = 1280;
constexpr int UPK = 384, UPN = 1792;
constexpr int ZW1 = 4096;

constexpr size_t SZ_GU = (size_t)2 * DFF * DM * 2, SZ_DN = (size_t)DM * DFF * 2, SZ_IN0 = (size_t)ZW0 * DM * 2, SZ_UP = (size_t)UPN * UPK * 2, SZ_OUT = (size_t)DM * DM * 2, SZ_IN1 = (size_t)ZW1 * DM * 2;
constexpr size_t CTL_BYTES = 65536;
constexpr size_t O_GU0A = CTL_BYTES, O_DN0A = O_GU0A + SZ_GU, O_GU0B = O_DN0A + SZ_DN, O_DN0B = O_GU0B + SZ_GU, O_GU1A = O_DN0B + SZ_DN, O_DN1A = O_GU1A + SZ_GU, O_GU1B = O_DN1A + SZ_DN, O_DN1B = O_GU1B + SZ_GU;
constexpr size_t O_IN0 = O_DN1B + SZ_DN, O_UP = O_IN0 + SZ_IN0, O_OUT0 = O_UP + SZ_UP, O_IN1 = O_OUT0 + SZ_OUT, O_OUT1 = O_IN1 + SZ_IN1;
constexpr size_t O_MODP = O_OUT1 + SZ_OUT, SZ_MODP = (size_t)2 * 16 * 9 * 9216 * 4, O_MOD = O_MODP + SZ_MODP, SZ_MOD = (size_t)2 * 9 * 9216 * 4;
constexpr size_t O_XC = O_MOD + SZ_MOD, SZ_XC = (size_t)NCTX * DM * 4;
constexpr size_t O_H = O_XC + SZ_XC, SZ_H = (size_t)NTOK * DM * 2;
constexpr size_t O_R = O_H + SZ_H;
constexpr size_t O_HID = O_R, SZ_HID = (size_t)NTOK * DFF * 2;
constexpr size_t O_Z0 = O_R, SZ_Z0 = (size_t)NTOK * UPN * 2;
constexpr size_t O_CN = O_Z0 + SZ_Z0, SZ_CN = (size_t)NTOK * UPK * 2;
constexpr size_t O_QM = O_CN + SZ_CN, SZ_QM = (size_t)NTOK * 768 * 2;
constexpr size_t O_KM = O_QM + SZ_QM, SZ_KM = (size_t)8 * 8 * NKEY * 96 * 2;
constexpr size_t O_VM = O_KM + SZ_KM, SZ_VM = (size_t)8 * 8 * NKEY * 64 * 2;
constexpr size_t O_KW = O_VM + SZ_VM, SZ_KW = (size_t)8 * 2 * NKEY * 64 * 2;
constexpr size_t O_VW = O_KW + SZ_KW;
constexpr size_t O_QW = O_VW + SZ_KW, SZ_QW = (size_t)NTOK * 512 * 2;
constexpr size_t O_END0 = O_QW + SZ_QW;
constexpr size_t O_Z1 = O_R, SZ_Z1 = (size_t)NTOK * ZW1 * 2;
constexpr size_t O_OB = O_Z1 + SZ_Z1, SZ_OB = (size_t)NLAT * DM * 2;
constexpr size_t O_END1 = O_OB + SZ_OB;
constexpr size_t WS_NEED = (O_END1 > O_END0 ? O_END1 : O_END0) > (O_HID + SZ_HID) ? (O_END1 > O_END0 ? O_END1 : O_END0) : (O_HID + SZ_HID);
static_assert(O_R % 256 == 0 && O_CN % 256 == 0 && O_OB % 256 == 0, "alignment");

#define GAS __attribute__((address_space(1)))
#define LDS_WAIT() asm volatile("s_waitcnt lgkmcnt(0)" ::: "memory")
typedef __bf16 bf16v2_t __attribute__((ext_vector_type(2)));
typedef float f32x2_t __attribute__((ext_vector_type(2)));
__device__ __forceinline__ unsigned pk2(float lo, float hi) { return __builtin_bit_cast(unsigned, __builtin_convertvector((f32x2_t){lo, hi}, bf16v2_t)); }
__device__ __forceinline__ unsigned f2bf(float f) { return pk2(f, f) & 0xffffu; }
__device__ __forceinline__ float bf2f(unsigned short h) { return __builtin_bit_cast(float, (unsigned)h << 16); }
__device__ __forceinline__ float bflo(unsigned w) { return __builtin_bit_cast(float, w << 16); }
__device__ __forceinline__ float bfhi(unsigned w) { return __builtin_bit_cast(float, w & 0xffff0000u); }
__device__ __forceinline__ float wave_sum(float v) {
#pragma unroll
    for (int o = 1; o < 64; o <<= 1) v += __shfl_xor(v, o);
    return v;
}
__device__ __forceinline__ float silu_f(float x) { return x * __builtin_amdgcn_rcpf(1.0f + __builtin_amdgcn_exp2f(-1.4426950408889634f * x)); }

struct Args { const float* in[38]; float* out; unsigned char* ws; };

__device__ __forceinline__ void tr_item(const float* W, int ldw, int k0, int n0, bf16* WT, int ldt, int drow0, int dcol0, LAS float* scr, int lane) {
#pragma unroll 8
    for (int i = 0; i < 32; ++i) { const int kk = 2 * i + (lane >> 5); scr[kk * 33 + (lane & 31)] = W[(size_t)(k0 + kk) * ldw + n0 + (lane & 31)]; }
    LDS_WAIT(); asm volatile("" ::: "memory");
    const int c = lane & 7;
#pragma unroll
    for (int j = 0; j < 4; ++j) { const int n = (lane >> 3) + 8 * j; const LAS float* s = scr + (8 * c) * 33 + n;
        v4u o; o.x = pk2(s[0 * 33], s[1 * 33]); o.y = pk2(s[2 * 33], s[3 * 33]); o.z = pk2(s[4 * 33], s[5 * 33]); o.w = pk2(s[6 * 33], s[7 * 33]);
        *(v4u*)(WT + (size_t)(drow0 + n) * ldt + dcol0 + 8 * c) = o; }
    LDS_WAIT(); asm volatile("" ::: "memory");
}
__device__ __forceinline__ void tr_matrix(const float* W, int K, int N, bf16* WT, int mode, LAS float* scr, int lane, int gw, int NGW) {
    const int nblk = N / 32, items = (K / 64) * nblk;
    for (int it = gw; it < items; it += NGW) {
        const int kb = it / nblk, nb = it % nblk, n0 = nb * 32;
        int drow = n0;
        if (mode == 1) { const int half = n0 >= DFF ? 1 : 0, j = n0 - half * DFF; drow = (j >> 7) * 256 + half * 128 + (j & 127); }
        tr_item(W, N, kb * 64, n0, WT, K, drow, kb * 64, scr, lane);
    }
}

__device__ __forceinline__ void phase0(const Args& a, LAS unsigned char* lds, int tid, int lane, int wave, int G) {
    unsigned char* ws = a.ws;
    {
        LAS float* sl = (LAS float*)lds;
        for (int item = blockIdx.x; item < 2 * 16 * 18; item += G) {
            const int l = item / (16 * 18), kc = (item / 18) % 16, cb = item % 18;
            __syncthreads();
            for (int e = tid; e < 9 * 64; e += NTHR) { const int b = e / 64, k = e % 64; const float cv = (b < 8) ? a.in[1][b * DM + kc * 64 + k] : a.in[3][kc * 64 + k]; sl[e] = silu_f(cv); }
            __syncthreads();
            const float* wm = a.in[l == 0 ? 5 : 25] + (size_t)(kc * 64) * 9216 + cb * 512 + tid;
            float acc[9];
#pragma unroll
            for (int b = 0; b < 9; ++b) acc[b] = 0.f;
            for (int k = 0; k < 64; ++k) { const float w = wm[(size_t)k * 9216];
#pragma unroll
                for (int b = 0; b < 9; ++b) acc[b] += sl[b * 64 + k] * w; }
            float* mp = (float*)(ws + O_MODP) + ((size_t)(l * 16 + kc) * 9) * 9216 + cb * 512 + tid;
#pragma unroll
            for (int b = 0; b < 9; ++b) mp[(size_t)b * 9216] = acc[b];
        }
        __syncthreads();
    }
    LAS float* scr = (LAS float*)(lds + wave * 16384);
    const int gw = blockIdx.x * NWAVES + wave, NGW = G * NWAVES;
    tr_matrix(a.in[7], DM, 2 * DFF, (bf16*)(ws + O_GU0A), 1, scr, lane, gw, NGW);
    tr_matrix(a.in[9], DM, 2 * DFF, (bf16*)(ws + O_GU0B), 1, scr, lane, gw, NGW);
    tr_matrix(a.in[27], DM, 2 * DFF, (bf16*)(ws + O_GU1A), 1, scr, lane, gw, NGW);
    tr_matrix(a.in[29], DM, 2 * DFF, (bf16*)(ws + O_GU1B), 1, scr, lane, gw, NGW);
    tr_matrix(a.in[8], DFF, DM, (bf16*)(ws + O_DN0A), 0, scr, lane, gw, NGW);
    tr_matrix(a.in[10], DFF, DM, (bf16*)(ws + O_DN0B), 0, scr, lane, gw, NGW);
    tr_matrix(a.in[28], DFF, DM, (bf16*)(ws + O_DN1A), 0, scr, lane, gw, NGW);
    tr_matrix(a.in[30], DFF, DM, (bf16*)(ws + O_DN1B), 0, scr, lane, gw, NGW);
    tr_matrix(a.in[11], DM, 1184, (bf16*)(ws + O_IN0), 0, scr, lane, gw, NGW);
    tr_matrix(a.in[23], DM, DM, (bf16*)(ws + O_OUT0), 0, scr, lane, gw, NGW);
    tr_matrix(a.in[37], DM, DM, (bf16*)(ws + O_OUT1), 0, scr, lane, gw, NGW);
    for (int it = gw; it < 2 * 32; it += NGW) { const int kb = it / 32, nb = it % 32; tr_item(a.in[15], 1024, kb * 64, nb * 32, (bf16*)(ws + O_UP), UPK, nb * 32, kb * 64, scr, lane); }
    for (int it = gw; it < 4 * 24; it += NGW) { const int kb = it / 24, nb = it % 24; tr_item(a.in[14], 768, kb * 64, nb * 32, (bf16*)(ws + O_UP), UPK, 1024 + nb * 32, 128 + kb * 64, scr, lane); }
    for (int it = gw; it < 16 * 97; it += NGW) { const int kb = it / 97, nb = it % 97; if (nb == 48) continue;
        const int drow = nb < 48 ? nb * 32 : (nb < 65 ? 2560 + (nb - 49) * 32 : 3072 + (nb - 65) * 32);
        tr_item(a.in[31], 3104, kb * 64, nb * 32, (bf16*)(ws + O_IN1), DM, drow, kb * 64, scr, lane); }
    const int gt = blockIdx.x * NTHR + tid, NGT = G * NTHR;
    for (int it = gt; it < 1024 * 128; it += NGT) {
        const int n = it >> 7, k8 = (it & 127) * 8; const int dir = n >> 9, nn = n & 511;
        const float* wg = a.in[dir ? 34 : 32] + nn; const float* wi = a.in[31] + (size_t)k8 * 3104 + 1536 + 16 * dir;
        float wr[16];
#pragma unroll
        for (int r = 0; r < 16; ++r) wr[r] = wg[r * 512];
        float o[8];
#pragma unroll
        for (int e = 0; e < 8; ++e) { float s = 0.f;
#pragma unroll
            for (int r = 0; r < 16; ++r) s += wi[(size_t)e * 3104 + r] * wr[r];
            o[e] = s; }
        v4u w; w.x = pk2(o[0], o[1]); w.y = pk2(o[2], o[3]); w.z = pk2(o[4], o[5]); w.w = pk2(o[6], o[7]);
        *(v4u*)((bf16*)(ws + O_IN1) + (size_t)(1536 + n) * DM + k8) = w;
    }
    for (int it = gt; it < 96 * 128; it += NGT) *(v4u*)((bf16*)(ws + O_IN0) + (size_t)1184 * DM + (size_t)it * 8) = (v4u){0u, 0u, 0u, 0u};
    for (int it = gt; it < 1024 * 32; it += NGT) { const int r = it >> 5, c = it & 31; *(v4u*)((bf16*)(ws + O_UP) + (size_t)r * UPK + 128 + c * 8) = (v4u){0u, 0u, 0u, 0u}; }
    for (int it = gt; it < 768 * 16; it += NGT) { const int r = it >> 4, c = it & 15; *(v4u*)((bf16*)(ws + O_UP) + (size_t)(1024 + r) * UPK + c * 8) = (v4u){0u, 0u, 0u, 0u}; }
}
__device__ __forceinline__ void phase_modreduce(const Args& a, int tid, int G) {
    const int gt = blockIdx.x * NTHR + tid, NGT = G * NTHR;
    for (int it = gt; it < 2 * 9 * 9216; it += NGT) {
        const int l = it / (9 * 9216), r = it % (9 * 9216), n = r % 9216;
        const float* mp = (const float*)(a.ws + O_MODP) + (size_t)l * 16 * 9 * 9216 + r;
        float s = a.in[l == 0 ? 6 : 26][n];
        for (int kc = 0; kc < 16; ++kc) s += mp[(size_t)kc * 9 * 9216];
        ((float*)(a.ws + O_MOD))[it] = s;
    }
}
__device__ __forceinline__ void phase_norm(const float* __restrict__ xl, const float* __restrict__ xc, int nrows, const float* ng, const float* modl, int sub, bf16* __restrict__ H, int lane, int gw, int NGW) {
    const int per = (nrows + NGW - 1) / NGW, rb = gw * per, re = (rb + per) < nrows ? (rb + per) : nrows;
    if (rb >= re) return;
    int curb = -1; f32x4 G[4], S0[4];
#pragma unroll
    for (int j = 0; j < 4; ++j) { G[j] = (f32x4){0.f, 0.f, 0.f, 0.f}; S0[j] = G[j]; }
    f32x4 v[4], v1[4];
#define NORM_LD(dst, r_) do { const int rr_ = (r_) < re ? (r_) : re - 1; const float* src_ = rr_ >= NLAT ? xc + (size_t)(rr_ - NLAT) * DM : xl + (size_t)rr_ * DM; const f32x4* xr_ = (const f32x4*)src_ + lane; \
        _Pragma("unroll") for (int j = 0; j < 4; ++j) dst[j] = __builtin_nontemporal_load(xr_ + 64 * j); } while (0)
    NORM_LD(v, rb); NORM_LD(v1, rb + 1);
#pragma unroll 1
    for (int row = rb; row < re; ++row) {
        f32x4 vn[4];
        NORM_LD(vn, row + 2);
        const int b = row >= NLAT ? 8 : (row >> 13);
        if (b != curb) { curb = b;
            const f32x4* gp = (const f32x4*)ng + lane; const f32x4* sh = (const f32x4*)(modl + (size_t)b * 9216 + (3 * sub) * DM) + lane; const f32x4* sc = (const f32x4*)(modl + (size_t)b * 9216 + (3 * sub + 1) * DM) + lane;
#pragma unroll
            for (int j = 0; j < 4; ++j) { G[j] = gp[64 * j] * (1.0f + sc[64 * j]); S0[j] = sh[64 * j]; } }
        float ss = 0.f;
#pragma unroll
        for (int j = 0; j < 4; ++j) ss += (v[j].x * v[j].x + v[j].y * v[j].y) + (v[j].z * v[j].z + v[j].w * v[j].w);
        const float rstd = rsqrtf(wave_sum(ss) * (1.0f / DM) + 1e-6f);
        unsigned long long* o8 = (unsigned long long*)(H + (size_t)row * DM) + lane;
#pragma unroll
        for (int j = 0; j < 4; ++j) { const f32x4 h = v[j] * rstd * G[j] + S0[j];
            o8[64 * j] = (unsigned long long)pk2(h.x, h.y) | ((unsigned long long)pk2(h.z, h.w) << 32); }
#pragma unroll
        for (int j = 0; j < 4; ++j) { v[j] = v1[j]; v1[j] = vn[j]; }
    }
#undef NORM_LD
}
#define XB_TMO      128
#define XB_XCNT(j)  (256  + 64 * (j))
#define XB_XSUB(j)  (1280 + 64 * (j))
#define XB_XGEN(j)  (2304 + 64 * (j))
#define XB_TOP      3328
#define XB_TOPGEN   3392
#define XCD_BAR_WORDS 3456
#define XB_SPIN_CAP (1u << 18)

__device__ __forceinline__ unsigned xb_ld(unsigned* p)              { return __hip_atomic_load(p, __ATOMIC_RELAXED, __HIP_MEMORY_SCOPE_AGENT); }
__device__ __forceinline__ unsigned xb_add(unsigned* p, unsigned v) { return __hip_atomic_fetch_add(p, v, __ATOMIC_RELAXED, __HIP_MEMORY_SCOPE_AGENT); }
__device__ __forceinline__ unsigned xb_xcc_id() { return (unsigned)__builtin_amdgcn_s_getreg((3 << 11) | 20) & 0xFu; }
#define XB_SPIN(cond, bar) do { unsigned _sp = 0; while (cond) { __builtin_amdgcn_s_sleep(1); \
    if ((++_sp & 255u) == 0u) { if (xb_ld(&(bar)[XB_TMO])) break; if (_sp > XB_SPIN_CAP) { atomicAdd(&(bar)[XB_TMO], 1u); break; } } } } while (0)

struct XcdBarrier {
    unsigned* bar; unsigned x;
    volatile LAS unsigned* st;
};

__device__ __forceinline__ XcdBarrier xcd_barrier_post(unsigned* bar, volatile LAS unsigned* st) {
    XcdBarrier b; b.bar = bar; b.x = xb_xcc_id(); b.st = st;
    if (threadIdx.x == 0) (void)xb_add(&bar[XB_XCNT(b.x)], 1u);
    return b;
}
__device__ __forceinline__ void xcd_barrier_complete(unsigned* bar, unsigned x, unsigned& nloc, unsigned& nx) {
    const unsigned G = gridDim.x * gridDim.y * gridDim.z;
    unsigned sum, cnt, mine, sp = 0u;
    for (;;) {
        sum = 0u; cnt = 0u; mine = 0u;
#pragma unroll
        for (unsigned j = 0; j < 16; ++j) { const unsigned c = xb_ld(&bar[XB_XCNT(j)]); sum += c; cnt += (c > 0u) ? 1u : 0u; mine = (j == x) ? c : mine; }
        if (sum == G) break;
        __builtin_amdgcn_s_sleep(1);
        if ((++sp & 255u) == 0u) { if (xb_ld(&bar[XB_TMO])) break; if (sp > XB_SPIN_CAP) { atomicAdd(&bar[XB_TMO], 1u); break; } }
    }
    nloc = mine > 0u ? mine : 1u; nx = cnt > 0u ? cnt : 1u;
}

__device__ __forceinline__ void xcd_barrier(const XcdBarrier& b) {
    asm volatile("s_waitcnt vmcnt(0)" ::: "memory");
    __syncthreads();
    if (threadIdx.x == 0) {
        unsigned* bar = b.bar;
        __builtin_amdgcn_s_waitcnt(0);
        unsigned nloc = b.st[0], nx = b.st[1];
        if (nloc == 0u) { xcd_barrier_complete(bar, b.x, nloc, nx); b.st[0] = nloc; b.st[1] = nx; }
        const unsigned old = xb_add(&bar[XB_XSUB(b.x)], 1u);
        const unsigned gen = old / nloc;
        if (old + 1u == (gen + 1u) * nloc) {
            __builtin_amdgcn_fence(__ATOMIC_RELEASE, "agent");
            asm volatile("s_waitcnt vmcnt(0)" ::: "memory");
            const unsigned og = xb_add(&bar[XB_TOP], 1u);
            const unsigned tg = og / nx;
            if (og + 1u == (tg + 1u) * nx) xb_add(&bar[XB_TOPGEN], 1u);
            else XB_SPIN(xb_ld(&bar[XB_TOPGEN]) == tg, bar);
            __builtin_amdgcn_fence(__ATOMIC_ACQUIRE, "agent");
            xb_add(&bar[XB_XGEN(b.x)], 1u);
            asm volatile("s_waitcnt vmcnt(0)" ::: "memory");
        } else {
            XB_SPIN(xb_ld(&bar[XB_XGEN(b.x)]) == gen, bar);
            __builtin_amdgcn_fence(__ATOMIC_ACQUIRE, "agent");
            asm volatile("s_waitcnt vmcnt(0)" ::: "memory");
        }
    }
    __syncthreads();
}

#define MFMA16(a, b, c) __builtin_amdgcn_mfma_f32_16x16x32_bf16((a), (b), (c), 0, 0, 0)
constexpr int GQS = 136, GTS = 72;
__device__ __forceinline__ void gla_scan(const bf16* Z1, bf16* OF, bf16* OB, LAS unsigned char* lds, int tid, int lane, int wave, int G) {
    LAS bf16* Qd = (LAS bf16*)lds;
    LAS bf16* Ki = Qd + 64 * GQS;
    LAS bf16* KeT = Ki + 64 * GQS;
    LAS bf16* VT = KeT + 128 * GTS;
    LAS bf16* Am = VT + 64 * GTS;
    LAS bf16* ST = Am + 64 * GTS;
    LAS float* dec = (LAS float*)(ST + 64 * GQS);
    const int l15 = lane & 15, l4 = lane >> 4;
    for (int job = blockIdx.x; job < 256; job += G) {
        const int bh_ = 4 * (job & 7) + (job >> 6), sub_ = (job >> 3) & 7;
        const int b = bh_ >> 2, h = bh_ & 3, dir = sub_ >> 2, dvb = sub_ & 3;
        const int sgn = dir ? -1 : 1;
        bf16* Oout = dir ? OB : OF;
        const int dk = 16 * wave + l15, qd = l4;
        const int dke = dk & ~1; const int hsh = (dk & 1) ? 0 : 16;
#define GLA_SEL(x) __builtin_bit_cast(float, ((x) << hsh) & 0xffff0000u)
        const bf16* zk = Z1 + 128 * h + dke; const bf16* zq = Z1 + 2560 + 128 * h + dke; const bf16* zg = Z1 + (dir ? 2048 : 1536) + 128 * h + dke;
        const int tv = tid & 63, dvc = tid >> 6;
        const bf16* zv = Z1 + 512 + 256 * h + 64 * dvb + 8 * dvc;
        f32x4 sacc[4];
#pragma unroll
        for (int i = 0; i < 4; ++i) sacc[i] = (f32x4){0.f, 0.f, 0.f, 0.f};
        unsigned rg[1][16], rq[1][16], rk[1][16]; v4u rv[1];
        int r0 = NLAT + b * 256 + (dir ? 255 : 0);
#define GLA_LOAD(S, rr) do { _Pragma("unroll") for (int i = 0; i < 16; ++i) { const size_t ro = (size_t)((rr) + sgn * (16 * qd + i)) * ZW1; rg[S][i] = *(const unsigned*)(zg + ro); rq[S][i] = *(const unsigned*)(zq + ro); rk[S][i] = *(const unsigned*)(zk + ro); } \
            rv[S] = *(const v4u*)(zv + (size_t)((rr) + sgn * tv) * ZW1); } while (0)
        GLA_LOAD(0, r0);
#pragma unroll 1
        for (int c = 0; c < 132; ++c) {
          { constexpr int S = 0;
            const int rcur = r0;
            __syncthreads();
            { const int dkh = wave >> 2, dvs = wave & 3;
#pragma unroll
              for (int dkt = 0; dkt < 4; ++dkt) { v2u w; w.x = pk2(sacc[dkt][0], sacc[dkt][1]); w.y = pk2(sacc[dkt][2], sacc[dkt][3]);
                  *(LAS v2u*)(ST + (16 * dvs + l15) * GQS + 64 * dkh + 16 * dkt + 4 * l4) = w; } }
#ifdef PROBE_GLA_T2
#pragma unroll 1
            for (int rep_ = 0; rep_ < 2; ++rep_)
#endif
            {
                float p[16]; float run = 0.f;
#pragma unroll
                for (int i = 0; i < 16; ++i) { run += GLA_SEL(rg[S][i]); p[i] = run; }
                const float t0 = __shfl(run, l15), t1 = __shfl(run, l15 + 16), t2 = __shfl(run, l15 + 32), t3 = __shfl(run, l15 + 48);
                const float off = (qd > 0 ? t0 : 0.f) + (qd > 1 ? t1 : 0.f) + (qd > 2 ? t2 : 0.f), bend = (t0 + t1) + (t2 + t3);
                float ke[16]; const float eend = __builtin_amdgcn_exp2f(bend);
                const int dksw = dk ^ (16 * qd);
#pragma unroll
                for (int i = 0; i < 16; ++i) {
                    const float bb = p[i] + off, qv = GLA_SEL(rq[S][i]), kv = GLA_SEL(rk[S][i]);
                    const float ei = __builtin_amdgcn_exp2f(-bb);
                    Qd[(16 * qd + i) * GQS + dksw] = (bf16)pk2(qv * __builtin_amdgcn_exp2f(bb), 0.f);
                    Ki[(16 * qd + i) * GQS + dksw] = (bf16)pk2(kv * ei, 0.f);
                    ke[i] = kv * (eend * ei);
                }
                v4u w0, w1;
                w0.x = pk2(ke[0], ke[1]); w0.y = pk2(ke[2], ke[3]); w0.z = pk2(ke[4], ke[5]); w0.w = pk2(ke[6], ke[7]);
                w1.x = pk2(ke[8], ke[9]); w1.y = pk2(ke[10], ke[11]); w1.z = pk2(ke[12], ke[13]); w1.w = pk2(ke[14], ke[15]);
                *(LAS v4u*)(KeT + dk * GTS + 16 * qd) = w0; *(LAS v4u*)(KeT + dk * GTS + 16 * qd + 8) = w1;
                if (qd == 0) dec[dk] = eend;
                VT[(8 * dvc + 0) * GTS + tv] = (bf16)(rv[S].x & 0xffffu); VT[(8 * dvc + 1) * GTS + tv] = (bf16)(rv[S].x >> 16);
                VT[(8 * dvc + 2) * GTS + tv] = (bf16)(rv[S].y & 0xffffu); VT[(8 * dvc + 3) * GTS + tv] = (bf16)(rv[S].y >> 16);
                VT[(8 * dvc + 4) * GTS + tv] = (bf16)(rv[S].z & 0xffffu); VT[(8 * dvc + 5) * GTS + tv] = (bf16)(rv[S].z >> 16);
                VT[(8 * dvc + 6) * GTS + tv] = (bf16)(rv[S].w & 0xffffu); VT[(8 * dvc + 7) * GTS + tv] = (bf16)(rv[S].w >> 16);
            }
            if (c + 1 < 132) {
                r0 = (c + 1 < 4) ? (NLAT + b * 256 + (dir ? 255 - 64 * (c + 1) : 64 * (c + 1))) : (b * SEQ + (dir ? SEQ - 1 - 64 * (c + 1 - 4) : 64 * (c + 1 - 4)));
                GLA_LOAD(0, r0);
            }
            __syncthreads();
#ifdef PROBE_GLA_T3
#pragma unroll 1
            for (int rep_ = 0; rep_ < 2; ++rep_)
#endif
            if (c >= 4) {
#pragma unroll
                for (int q = 0; q < 2; ++q) {
                    const int tile = 2 * wave + q, ti = tile >> 2, si = tile & 3;
                    f32x4 acc = (f32x4){0.f, 0.f, 0.f, 0.f};
                    if (si <= ti) {
#pragma unroll
                        for (int ks = 0; ks < 4; ++ks) {
                            const bf16x8 A = *(const LAS bf16x8*)(Ki + (16 * si + l15) * GQS + ((32 * ks + 8 * l4) ^ (16 * si)));
                            const bf16x8 B = *(const LAS bf16x8*)(Qd + (16 * ti + l15) * GQS + ((32 * ks + 8 * l4) ^ (16 * ti)));
                            acc = MFMA16(A, B, acc);
                        }
                    }
                    const int t = 16 * ti + l15, s0 = 16 * si + 4 * l4;
                    v2u w; w.x = pk2(s0 + 0 <= t ? acc[0] : 0.f, s0 + 1 <= t ? acc[1] : 0.f); w.y = pk2(s0 + 2 <= t ? acc[2] : 0.f, s0 + 3 <= t ? acc[3] : 0.f);
                    *(LAS v2u*)(Am + t * GTS + s0) = w;
                }
            }
            __syncthreads();
#ifdef PROBE_GLA_T4
#pragma unroll 1
            for (int rep_ = 0; rep_ < 2; ++rep_)
#endif
            if (c >= 4) {
                const int tq = wave >> 2, dvs = wave & 3;
#pragma unroll
                for (int q = 0; q < 2; ++q) {
                    const int tt = 2 * tq + q;
                    f32x4 acc = (f32x4){0.f, 0.f, 0.f, 0.f};
#pragma unroll
                    for (int ks = 0; ks < 2; ++ks) {
                        const bf16x8 A = *(const LAS bf16x8*)(VT + (16 * dvs + l15) * GTS + 32 * ks + 8 * l4);
                        const bf16x8 B = *(const LAS bf16x8*)(Am + (16 * tt + l15) * GTS + 32 * ks + 8 * l4);
                        acc = MFMA16(A, B, acc);
                    }
#pragma unroll
                    for (int ks = 0; ks < 4; ++ks) {
                        const bf16x8 A = *(const LAS bf16x8*)(ST + (16 * dvs + l15) * GQS + 32 * ks + 8 * l4);
                        const bf16x8 B = *(const LAS bf16x8*)(Qd + (16 * tt + l15) * GQS + ((32 * ks + 8 * l4) ^ (16 * tt)));
                        acc = MFMA16(A, B, acc);
                    }
                    const int row = rcur + sgn * (16 * tt + l15);
                    v2u w; w.x = pk2(acc[0], acc[1]); w.y = pk2(acc[2], acc[3]);
                    *(v2u*)(Oout + (size_t)row * DM + 256 * h + 64 * dvb + 16 * dvs + 4 * l4) = w;
                }
            }
            { const int dkh = wave >> 2, dvs = wave & 3;
#pragma unroll
              for (int dkt = 0; dkt < 4; ++dkt) {
                  const int dk0 = 64 * dkh + 16 * dkt;
                  const f32x4 d4 = *(const LAS f32x4*)(dec + dk0 + 4 * l4);
                  sacc[dkt] = sacc[dkt] * d4;
#pragma unroll
                  for (int ks = 0; ks < 2; ++ks) {
                      const bf16x8 A = *(const LAS bf16x8*)(KeT + (dk0 + l15) * GTS + 32 * ks + 8 * l4);
                      const bf16x8 B = *(const LAS bf16x8*)(VT + (16 * dvs + l15) * GTS + 32 * ks + 8 * l4);
                      sacc[dkt] = MFMA16(A, B, sacc[dkt]);
                  }
              } }
          }
        }
#undef GLA_LOAD
#undef GLA_SEL
        __syncthreads();
    }
}
__device__ __forceinline__ void gla_combine(bf16* OF, const bf16* OB, const bf16* Z1, const float* gnorm, int lane, int gw, int NGW) {
    for (int row = gw; row < NLAT; row += NGW) {
        const v4u* pf = (const v4u*)(OF + (size_t)row * DM + 16 * lane); const v4u* pb = (const v4u*)(OB + (size_t)row * DM + 16 * lane);
        const v4u* pg = (const v4u*)(Z1 + (size_t)row * ZW1 + 3072 + 16 * lane);
        const v4u f0 = pf[0], f1 = pf[1], b0 = pb[0], b1 = pb[1], g0 = pg[0], g1 = pg[1];
        const unsigned fw[8] = {f0.x, f0.y, f0.z, f0.w, f1.x, f1.y, f1.z, f1.w}, bw[8] = {b0.x, b0.y, b0.z, b0.w, b1.x, b1.y, b1.z, b1.w}, gwd[8] = {g0.x, g0.y, g0.z, g0.w, g1.x, g1.y, g1.z, g1.w};
        float o[16]; float ss = 0.f;
#pragma unroll
        for (int e = 0; e < 8; ++e) { o[2 * e] = bflo(fw[e]) + bflo(bw[e]); o[2 * e + 1] = bfhi(fw[e]) + bfhi(bw[e]); ss += o[2 * e] * o[2 * e] + o[2 * e + 1] * o[2 * e + 1]; }
        ss += __shfl_xor(ss, 1); ss += __shfl_xor(ss, 2); ss += __shfl_xor(ss, 4); ss += __shfl_xor(ss, 8);
        const float rstd = rsqrtf(ss * (1.0f / 256.0f) + 1e-6f);
        const float* gn = gnorm + 16 * (lane & 15);
        unsigned ow[8];
#pragma unroll
        for (int e = 0; e < 8; ++e) { const float ga = bflo(gwd[e]), gb = bfhi(gwd[e]);
            ow[e] = pk2(o[2 * e] * rstd * gn[2 * e] * silu_f(ga), o[2 * e + 1] * rstd * gn[2 * e + 1] * silu_f(gb)); }
        v4u* po = (v4u*)(OF + (size_t)row * DM + 16 * lane);
        po[0] = (v4u){ow[0], ow[1], ow[2], ow[3]}; po[1] = (v4u){ow[4], ow[5], ow[6], ow[7]};
    }
}

#define MFMA32(a, b, c) __builtin_amdgcn_mfma_f32_32x32x16_bf16((a), (b), (c), 0, 0, 0)
constexpr float LOG2E = 1.4426950408889634f;
constexpr float QS_MLA = 0.10206207261596577f * LOG2E;
constexpr float QS_WIN = 0.125f * LOG2E;
constexpr float LOG2_ROPE = 13.287712379549449f;
constexpr float RESCALE_THR = 8.0f;

__device__ __forceinline__ void rope2(float& x1, float& x2, float ang) { const float s = __sinf(ang), c = __cosf(ang);   const float a = x1 * c - x2 * s, b = x1 * s + x2 * c; x1 = a; x2 = b; }

__device__ __forceinline__ void prep1(const Args& a, const bf16* __restrict__ Z0, bf16* __restrict__ CN, bf16* __restrict__ KM, bf16* __restrict__ KW, bf16* __restrict__ VW, bf16* __restrict__ QW, int lane, int gw, int NGW) {
    const float* g_qa = a.in[12]; const float* g_kva = a.in[13]; const float* g_kr = a.in[19]; const float* g_q = a.in[20]; const float* g_k = a.in[21];
    const float inv_kr = __builtin_amdgcn_exp2f(-(float)(lane & 7) * (LOG2_ROPE / 8.0f));
    const float inv_wk = __builtin_amdgcn_exp2f(-(float)(lane & 15) * (LOG2_ROPE / 16.0f));
    float inv_wq[4];
#pragma unroll
    for (int p = 0; p < 4; ++p) inv_wq[p] = __builtin_amdgcn_exp2f(-(float)((4 * (lane & 7) + p) & 15) * (LOG2_ROPE / 16.0f));
#pragma unroll 2
    for (int r = gw; r < NTOK; r += NGW) {
        const bool isc = r >= NLAT;
        int b, n; float prow = 0.f, pcol = 0.f;
        if (!isc) { b = r >> 13; const int t = r & (SEQ - 1); n = CTXL + t; prow = (float)(t >> 6); pcol = (float)(t & 63); } else { const int rc = r - NLAT; b = rc >> 8; n = rc & 255; }
        const bf16* zr = Z0 + (size_t)r * ZW0;
        {
            const unsigned w = __builtin_nontemporal_load((const unsigned*)(zr + 2 * lane)); float x0 = bflo(w), x1 = bfhi(w);
            const float rstd = rsqrtf(wave_sum(x0 * x0 + x1 * x1) * (1.0f / 128.0f) + 1e-6f);
            *(unsigned*)(CN + (size_t)r * UPK + 2 * lane) = pk2(x0 * rstd * g_kva[2 * lane], x1 * rstd * g_kva[2 * lane + 1]);
        }
        {
            const v2u w = __builtin_nontemporal_load((const v2u*)(zr + 416 + 4 * lane)); float x0 = bflo(w.x), x1 = bfhi(w.x), x2 = bflo(w.y), x3 = bfhi(w.y);
            const float rstd = rsqrtf(wave_sum((x0 * x0 + x1 * x1) + (x2 * x2 + x3 * x3)) * (1.0f / 256.0f) + 1e-6f);
            const f32x4 g = *(const f32x4*)(g_qa + 4 * lane);
            v2u o; o.x = pk2(x0 * rstd * g.x, x1 * rstd * g.y); o.y = pk2(x2 * rstd * g.z, x3 * rstd * g.w);
            *(v2u*)(CN + (size_t)r * UPK + 128 + 4 * lane) = o;
        }
        {
            float x0 = 0.f, x1 = 0.f;
            if (lane < 16) { const unsigned w = *(const unsigned*)(zr + 128 + 2 * lane); x0 = bflo(w); x1 = bfhi(w); }
            const float rstd = rsqrtf(wave_sum(x0 * x0 + x1 * x1) * (1.0f / 32.0f) + 1e-6f);
            if (lane < 16) {
                x0 *= rstd * g_kr[2 * lane]; x1 *= rstd * g_kr[2 * lane + 1];
                if (!isc) rope2(x0, x1, (lane < 8 ? prow : pcol) * inv_kr);
                const unsigned o = pk2(x0, x1);
#pragma unroll
                for (int h = 0; h < 8; ++h) *(unsigned*)(KM + ((size_t)(b * 8 + h) * NKEY + n) * 96 + 64 + 2 * lane) = o;
            }
        }
        {
            const int hk = lane >> 5, i = lane & 31;
            const unsigned w = __builtin_nontemporal_load((const unsigned*)(zr + 160 + 2 * lane)); float x0 = bflo(w), x1 = bfhi(w);
            float ss = x0 * x0 + x1 * x1;
            ss += __shfl_xor(ss, 1); ss += __shfl_xor(ss, 2); ss += __shfl_xor(ss, 4); ss += __shfl_xor(ss, 8); ss += __shfl_xor(ss, 16);
            const float rstd = rsqrtf(ss * (1.0f / 64.0f) + 1e-6f);
            x0 *= rstd * g_k[2 * i]; x1 *= rstd * g_k[2 * i + 1];
            if (!isc) rope2(x0, x1, (i < 16 ? prow : pcol) * inv_wk);
            const size_t ko = ((size_t)(b * 2 + hk) * NKEY + n) * 64 + 2 * i;
            *(unsigned*)(KW + ko) = pk2(x0, x1);
            *(unsigned*)(VW + ko) = *(const unsigned*)(zr + 288 + 2 * lane);
        }
        {
            const int j = lane & 7;
            const v4u w = __builtin_nontemporal_load((const v4u*)(zr + 672 + 8 * lane));
            float x[8] = {bflo(w.x), bfhi(w.x), bflo(w.y), bfhi(w.y), bflo(w.z), bfhi(w.z), bflo(w.w), bfhi(w.w)};
            float ss = 0.f;
#pragma unroll
            for (int e = 0; e < 8; ++e) ss += x[e] * x[e];
            ss += __shfl_xor(ss, 1); ss += __shfl_xor(ss, 2); ss += __shfl_xor(ss, 4);
            const float rstd = rsqrtf(ss * (1.0f / 64.0f) + 1e-6f);
            const f32x4 g0 = *(const f32x4*)(g_q + 8 * j), g1 = *(const f32x4*)(g_q + 8 * j + 4);
            const float gg[8] = {g0.x, g0.y, g0.z, g0.w, g1.x, g1.y, g1.z, g1.w};
#pragma unroll
            for (int e = 0; e < 8; ++e) x[e] *= rstd * gg[e];
            if (!isc) {
                const float pos = (j < 4) ? prow : pcol;
#pragma unroll
                for (int p = 0; p < 4; ++p) rope2(x[2 * p], x[2 * p + 1], pos * inv_wq[p]);
            }
            v4u o; o.x = pk2(x[0] * QS_WIN, x[1] * QS_WIN); o.y = pk2(x[2] * QS_WIN, x[3] * QS_WIN); o.z = pk2(x[4] * QS_WIN, x[5] * QS_WIN); o.w = pk2(x[6] * QS_WIN, x[7] * QS_WIN);
            *(v4u*)(QW + (size_t)r * 512 + 8 * lane) = o;
        }
    }
}
__device__ __forceinline__ void prep2(const Args& a, const bf16* __restrict__ KVQ, bf16* __restrict__ KM, bf16* __restrict__ VM, bf16* __restrict__ QM, int lane, int gw, int NGW) {
    const float* g_qn = a.in[16]; const float* g_qr = a.in[17]; const float* g_kn = a.in[18];
    const int hh = lane >> 3, j = lane & 7;
    float inv_qr[2];
#pragma unroll
    for (int p = 0; p < 2; ++p) inv_qr[p] = __builtin_amdgcn_exp2f(-(float)((2 * j + p) & 7) * (LOG2_ROPE / 8.0f));
#pragma unroll 2
    for (int r = gw; r < NTOK; r += NGW) {
        const bool isc = r >= NLAT;
        int b, n; float prow = 0.f, pcol = 0.f;
        if (!isc) { b = r >> 13; const int t = r & (SEQ - 1); n = CTXL + t; prow = (float)(t >> 6); pcol = (float)(t & 63); } else { const int rc = r - NLAT; b = rc >> 8; n = rc & 255; }
        const bf16* kr = KVQ + (size_t)r * UPN;
        {
            const v4u w0 = __builtin_nontemporal_load((const v4u*)(kr + 16 * lane)), w1 = __builtin_nontemporal_load((const v4u*)(kr + 16 * lane + 8));
            const unsigned ww[8] = {w0.x, w0.y, w0.z, w0.w, w1.x, w1.y, w1.z, w1.w};
            float ss = 0.f;
#pragma unroll
            for (int e = 0; e < 8; ++e) { const float p0 = bflo(ww[e]), p1 = bfhi(ww[e]); ss += p0 * p0 + p1 * p1; }
            ss += __shfl_xor(ss, 1); ss += __shfl_xor(ss, 2);
            if (j < 4) {
                const float rstd = rsqrtf(ss * (1.0f / 64.0f) + 1e-6f);
                const float* gp = g_kn + 16 * j; unsigned o[8];
#pragma unroll
                for (int e = 0; e < 8; ++e) o[e] = pk2(bflo(ww[e]) * rstd * gp[2 * e], bfhi(ww[e]) * rstd * gp[2 * e + 1]);
                bf16* dst = KM + ((size_t)(b * 8 + hh) * NKEY + n) * 96 + 16 * j;
                *(v4u*)dst = (v4u){o[0], o[1], o[2], o[3]}; *(v4u*)(dst + 8) = (v4u){o[4], o[5], o[6], o[7]};
            } else {
                bf16* dst = VM + ((size_t)(b * 8 + hh) * NKEY + n) * 64 + 16 * (j - 4);
                *(v4u*)dst = w0; *(v4u*)(dst + 8) = w1;
            }
        }
        {
            const v4u w = __builtin_nontemporal_load((const v4u*)(kr + 1024 + 96 * hh + 8 * j));
            float x[8] = {bflo(w.x), bfhi(w.x), bflo(w.y), bfhi(w.y), bflo(w.z), bfhi(w.z), bflo(w.w), bfhi(w.w)};
            float ss = 0.f;
#pragma unroll
            for (int e = 0; e < 8; ++e) ss += x[e] * x[e];
            ss += __shfl_xor(ss, 1); ss += __shfl_xor(ss, 2); ss += __shfl_xor(ss, 4);
            const float rstd = rsqrtf(ss * (1.0f / 64.0f) + 1e-6f) * QS_MLA;
            const f32x4 g0 = *(const f32x4*)(g_qn + 8 * j), g1 = *(const f32x4*)(g_qn + 8 * j + 4);
            v4u o; o.x = pk2(x[0] * rstd * g0.x, x[1] * rstd * g0.y); o.y = pk2(x[2] * rstd * g0.z, x[3] * rstd * g0.w);
            o.z = pk2(x[4] * rstd * g1.x, x[5] * rstd * g1.y); o.w = pk2(x[6] * rstd * g1.z, x[7] * rstd * g1.w);
            *(v4u*)(QM + (size_t)r * 768 + 96 * hh + 8 * j) = o;
        }
        {
            const v2u w = __builtin_nontemporal_load((const v2u*)(kr + 1024 + 96 * hh + 64 + 4 * j));
            float x0 = bflo(w.x), x1 = bfhi(w.x), x2 = bflo(w.y), x3 = bfhi(w.y);
            float ss = (x0 * x0 + x1 * x1) + (x2 * x2 + x3 * x3);
            ss += __shfl_xor(ss, 1); ss += __shfl_xor(ss, 2); ss += __shfl_xor(ss, 4);
            const float rstd = rsqrtf(ss * (1.0f / 32.0f) + 1e-6f);
            const f32x4 g = *(const f32x4*)(g_qr + 4 * j);
            x0 *= rstd * g.x; x1 *= rstd * g.y; x2 *= rstd * g.z; x3 *= rstd * g.w;
            if (!isc) { const float pos = (j < 4) ? prow : pcol; rope2(x0, x1, pos * inv_qr[0]); rope2(x2, x3, pos * inv_qr[1]); }
            v2u o; o.x = pk2(x0 * QS_MLA, x1 * QS_MLA); o.y = pk2(x2 * QS_MLA, x3 * QS_MLA);
            *(v2u*)(QM + (size_t)r * 768 + 96 * hh + 64 + 4 * j) = o;
        }
    }
}

typedef float f32x2 __attribute__((ext_vector_type(2)));
__device__ __forceinline__ float max3f(float a, float b, float c) { float r; asm("v_max3_f32 %0, %1, %2, %3" : "=v"(r) : "v"(a), "v"(b), "v"(c)); return r; }
template <int DQK, bool WIN>
__device__ __forceinline__ void attn_unit(const bf16* Qp, int qld, const bf16* Kb, const bf16* Vb, bf16* Op, int ntiles, int latj0, int qlat0, float m_init, float l_init,
                                          LAS unsigned char* lds, int tid, int lane, int wave) {
    constexpr int KS = DQK + 8, VS = 68, KCH = DQK / 8;
    constexpr int KBYTES = 64 * KS * 2, VBYTES = 64 * VS * 2;
    const int l31 = lane & 31, hh = lane >> 5;
    bf16x8 qf[DQK / 16];
    { const bf16* qr = Qp + (size_t)(32 * wave + l31) * qld + 8 * hh;
#pragma unroll
      for (int ks = 0; ks < DQK / 16; ++ks) qf[ks] = *(const bf16x8*)(qr + 16 * ks); }
    f32x16 ot[2];
#pragma unroll
    for (int i = 0; i < 16; ++i) { ot[0][i] = 0.f; ot[1][i] = 0.f; }
    float m = m_init, l = l_init;
    const int kc0 = tid, kc1 = tid + 512;
    const int vkey = tid & 63, vdc = tid >> 6;
    const bool has1 = (KCH * 64 > 512) && (kc1 < KCH * 64);
    const int kg0 = (kc0 / KCH) * DQK + 8 * (kc0 % KCH), kg1 = (kc1 / KCH) * DQK + 8 * (kc1 % KCH), vg = vkey * 64 + 8 * vdc;
    const int kl0 = (kc0 / KCH) * KS + 8 * (kc0 % KCH), kl1 = (kc1 / KCH) * KS + 8 * (kc1 % KCH), vl = (8 * vdc) * VS + vkey;
    v4u kA[4], kB[4], vR[4];
#pragma unroll
    for (int i = 0; i < 4; ++i) { kA[i] = (v4u){0u, 0u, 0u, 0u}; kB[i] = kA[i]; vR[i] = kA[i]; }
#define ATT_LOAD(jj, S) do { int j_ = (jj); j_ = j_ < ntiles ? j_ : ntiles - 1; const int n0_ = j_ < 4 ? 64 * j_ : CTXL + 64 * (latj0 + j_ - 4); \
        kA[S] = *(const v4u*)(Kb + (size_t)n0_ * DQK + kg0); if (has1) kB[S] = *(const v4u*)(Kb + (size_t)n0_ * DQK + kg1); vR[S] = *(const v4u*)(Vb + (size_t)n0_ * 64 + vg); } while (0)
#define ATT_STORE(kb, vb, S) do { LAS bf16* B_ = (LAS bf16*)(lds + (kb) * KBYTES); *(LAS v4u*)(B_ + kl0) = kA[S]; if (has1) *(LAS v4u*)(B_ + kl1) = kB[S]; \
        LAS bf16* vp_ = (LAS bf16*)(lds + 4 * KBYTES + (vb) * VBYTES) + vl; const v4u vr = vR[S]; \
        vp_[0 * VS] = (bf16)(vr.x & 0xffffu); vp_[1 * VS] = (bf16)(vr.x >> 16); vp_[2 * VS] = (bf16)(vr.y & 0xffffu); vp_[3 * VS] = (bf16)(vr.y >> 16); \
        vp_[4 * VS] = (bf16)(vr.z & 0xffffu); vp_[5 * VS] = (bf16)(vr.z >> 16); vp_[6 * VS] = (bf16)(vr.w & 0xffffu); vp_[7 * VS] = (bf16)(vr.w >> 16); } while (0)
#define ATT_QK(ST, kb, cc) do { const LAS bf16* Kl_ = (const LAS bf16*)(lds + (kb) * KBYTES); const float ni_ = -(cc); \
        _Pragma("unroll") for (int kt = 0; kt < 2; ++kt) { \
            _Pragma("unroll") for (int i = 0; i < 16; ++i) ST[kt][i] = ni_; \
            _Pragma("unroll") for (int ks = 0; ks < DQK / 16; ++ks) { \
                const bf16x8 A = *(const LAS bf16x8*)(Kl_ + (32 * kt + l31) * KS + 16 * ks + 8 * hh); \
                ST[kt] = MFMA32(A, qf[ks], ST[kt]); } } } while (0)
#define ATT_DECIDE(ST, cc, mxv) do { \
        if (__any((mxv) + (cc) > m + RESCALE_THR)) { \
            const float mr_ = fmaxf((mxv), __shfl_xor((mxv), 32)); \
            const float mn = fmaxf(m, mr_ + (cc)), alpha = __builtin_amdgcn_exp2f(m - mn); \
            m = mn; l *= alpha; \
            const f32x2 a2 = {alpha, alpha}; \
            _Pragma("unroll") for (int dt = 0; dt < 2; ++dt) \
                _Pragma("unroll") for (int i = 0; i < 8; ++i) { f32x2 v = {ot[dt][2 * i], ot[dt][2 * i + 1]}; v = v * a2; ot[dt][2 * i] = v.x; ot[dt][2 * i + 1] = v.y; } \
            const float dlt = (cc) - m; const f32x2 d2 = {dlt, dlt}; \
            _Pragma("unroll") for (int kt = 0; kt < 2; ++kt) \
                _Pragma("unroll") for (int i = 0; i < 8; ++i) { f32x2 v = {ST[kt][2 * i], ST[kt][2 * i + 1]}; v = v + d2; ST[kt][2 * i] = v.x; ST[kt][2 * i + 1] = v.y; } \
            cref = m; _Pragma("unroll") for (int i = 0; i < 16; ++i) negc[i] = -m; } } while (0)
#define ATT_ITER(j, S2, CUR, NXT, BAR) do { \
        ATT_STORE(((j) + 3) & 3, vst, S2); ATT_LOAD((j) + 7, S2); \
        const float c_next = cref;     \
        f32x2 ls2 = {0.f, 0.f}; \
        unsigned pw[2][8]; \
        float mxn; \
        { constexpr int KST = DQK / 16, NS = 2 * KST; \
          const LAS bf16* Kl_ = (const LAS bf16*)(lds + (((j) + 1) & 3) * KBYTES) + l31 * KS + 8 * hh; \
          const LAS bf16* Vt_ = (const LAS bf16*)(lds + 4 * KBYTES + vrd * VBYTES) + l31 * VS + 4 * hh; \
          bf16x8 kf[NS]; s16x4 vlo[8], vhi[8]; \
          kf[0] = *(const LAS bf16x8*)(Kl_); kf[1] = *(const LAS bf16x8*)(Kl_ + 16); \
          __builtin_amdgcn_sched_barrier(0); \
          _Pragma("unroll") for (int s_ = 0; s_ < NS; ++s_) { \
              if (s_ + 2 < NS) { const int kt2 = (s_ + 2) / KST, ks2 = (s_ + 2) % KST; kf[s_ + 2] = *(const LAS bf16x8*)(Kl_ + 32 * kt2 * KS + 16 * ks2); } \
              if (s_ + 2 >= NS) { const int e = s_ + 2 - NS; vlo[e] = *(const LAS s16x4*)(Vt_ + 32 * (e & 1) * VS + 32 * (e >> 2) + 16 * ((e >> 1) & 1)); vhi[e] = *(const LAS s16x4*)(Vt_ + 32 * (e & 1) * VS + 32 * (e >> 2) + 16 * ((e >> 1) & 1) + 8); } \
              { const int kt = s_ / KST, ks = s_ % KST; NXT[kt] = (ks == 0) ? MFMA32(kf[s_], qf[ks], negc) : MFMA32(kf[s_], qf[ks], NXT[kt]); } \
              { const int np = (NS == 8 || s_ < 4) ? 2 : 1, first = (NS == 8 || s_ < 4) ? 2 * s_ : s_ + 4; \
                _Pragma("unroll") for (int q_ = 0; q_ < np; ++q_) { const int pi = first + q_, kt = pi >> 3, i = pi & 7; \
                    f32x2 p; p.x = __builtin_amdgcn_exp2f(CUR[kt][2 * i]); p.y = __builtin_amdgcn_exp2f(CUR[kt][2 * i + 1]); ls2 = ls2 + p; pw[kt][i] = pk2(p.x, p.y); } } \
              __builtin_amdgcn_sched_barrier(0); \
          } \
          const int qq_ = qlat0 + 32 * wave + l31, kbase_ = 64 * (latj0 + (j) + 1 - 4) + 4 * hh; \
          mxn = -3.0e38f; \
          __builtin_amdgcn_s_setprio(1);     \
          _Pragma("unroll") for (int e = 0; e < 8; ++e) { \
              if (e + 2 < 8) { const int e2 = e + 2; vlo[e2] = *(const LAS s16x4*)(Vt_ + 32 * (e2 & 1) * VS + 32 * (e2 >> 2) + 16 * ((e2 >> 1) & 1)); vhi[e2] = *(const LAS s16x4*)(Vt_ + 32 * (e2 & 1) * VS + 32 * (e2 >> 2) + 16 * ((e2 >> 1) & 1) + 8); } \
              const int kt = e >> 2, sI = (e >> 1) & 1, dt = e & 1; \
              const v4u pv = {pw[kt][4 * sI], pw[kt][4 * sI + 1], pw[kt][4 * sI + 2], pw[kt][4 * sI + 3]}; \
              const bf16x8 pb = __builtin_bit_cast(bf16x8, pv); \
              const bf16x8 A = __builtin_shufflevector(vlo[e], vhi[e], 0, 1, 2, 3, 4, 5, 6, 7); \
              ot[dt] = MFMA32(A, pb, ot[dt]); \
              { const int kn = e >> 2, i0 = 4 * (e & 3);     \
                if (WIN && (j) + 1 >= 4) { \
                    _Pragma("unroll") for (int i = i0; i < i0 + 4; ++i) { const int kk = kbase_ + 32 * kn + (i & 3) + 8 * (i >> 2); const int d = qq_ - kk; if (d > 128 || d < -128) NXT[kn][i] = -1e30f; } } \
                mxn = max3f(mxn, NXT[kn][i0], NXT[kn][i0 + 1]); mxn = max3f(mxn, NXT[kn][i0 + 2], NXT[kn][i0 + 3]); } \
              __builtin_amdgcn_sched_barrier(0); \
          } \
          __builtin_amdgcn_s_setprio(0); } \
        l += ls2.x + ls2.y;     \
        ATT_DECIDE(NXT, c_next, mxn); \
        vrd = vrd == 4 ? 0 : vrd + 1; vst = vst == 4 ? 0 : vst + 1; \
        if (BAR) __syncthreads(); } while (0)
    ATT_LOAD(0, 0); ATT_LOAD(1, 1); ATT_LOAD(2, 2); ATT_LOAD(3, 3);
    ATT_STORE(0, 0, 0); ATT_STORE(1, 1, 1); ATT_STORE(2, 2, 2);
    ATT_LOAD(4, 0); ATT_LOAD(5, 1); ATT_LOAD(6, 2);
    __syncthreads();
    const float c0_ = m < -1e29f ? 0.f : m;
    float cref = c0_; f32x16 negc;
#pragma unroll
    for (int i = 0; i < 16; ++i) negc[i] = -c0_;
    int vrd = 0, vst = 3;
    f32x16 stA[2], stB[2];
    ATT_QK(stA, 0, c0_);
    { float mx0 = max3f(stA[0][0], stA[0][1], stA[1][0]);
#pragma unroll
      for (int i = 1; i < 8; ++i) mx0 = max3f(mx0, stA[0][2 * i], stA[0][2 * i + 1]);
#pragma unroll
      for (int i = 1; i < 8; ++i) mx0 = max3f(mx0, stA[1][2 * i], stA[1][2 * i + 1]);
      mx0 = fmaxf(mx0, stA[1][1]);
      ATT_DECIDE(stA, c0_, mx0); }
    __syncthreads();
#pragma unroll 1
    for (int j = 0; j < ntiles; j += 4) {
        ATT_ITER(j, 3, stA, stB, false);
        if (j + 1 < ntiles) ATT_ITER(j + 1, 0, stB, stA, true);
        if (j + 2 < ntiles) ATT_ITER(j + 2, 1, stA, stB, false);
        if (j + 3 < ntiles) ATT_ITER(j + 3, 2, stB, stA, true);
    }
#undef ATT_ITER
#undef ATT_DECIDE
#undef ATT_QK
#undef ATT_LOAD
#undef ATT_STORE
    l += __shfl_xor(l, 32);
    const float rl = 1.0f / l;
    bf16* orow = Op + (size_t)(32 * wave + l31) * DM + 4 * hh;
#pragma unroll
    for (int dt = 0; dt < 2; ++dt)
#pragma unroll
        for (int g = 0; g < 4; ++g) { v2u w; w.x = pk2(ot[dt][4 * g] * rl, ot[dt][4 * g + 1] * rl); w.y = pk2(ot[dt][4 * g + 2] * rl, ot[dt][4 * g + 3] * rl);
            *(v2u*)(orow + 32 * dt + 8 * g) = w; }
}

__device__ __forceinline__ void attn_phase(const Args& a, const bf16* QM, const bf16* KM, const bf16* VM, const bf16* QW, const bf16* KW, const bf16* VW, bf16* O,
                                           LAS unsigned char* lds, int tid, int lane_unused, int wave_unused, int G) {
    const float* sink = a.in[22];
    const int tid0_ = tid;
    for (int u = blockIdx.x; u < 4224; u += G) {
        int tid = tid0_; asm volatile("" : "+v"(tid));
        const int lane = tid & 63; const int wave = __builtin_amdgcn_readfirstlane(tid >> 6);
        if (u < 4096) {
            const int v = u & 2047; const int bh = (v & 7) + 8 * (v >> 8), qb = (v >> 3) & 31; const int b = bh >> 3, h = bh & 7;
            const int row0 = b * SEQ + 256 * qb;
            if (u < 2048) {
                attn_unit<96, false>(QM + (size_t)row0 * 768 + 96 * h, 768, KM + (size_t)bh * NKEY * 96, VM + (size_t)bh * NKEY * 64, O + (size_t)row0 * DM + 64 * h,
                                     132, 0, 0, -1e30f, 0.f, lds, tid, lane, wave);
            } else {
                const int hk = h >> 2; const int j0 = (4 * qb - 2) > 0 ? (4 * qb - 2) : 0, j1 = (4 * qb + 5) < 127 ? (4 * qb + 5) : 127;
                attn_unit<64, true>(QW + (size_t)row0 * 512 + 64 * h, 512, KW + (size_t)(b * 2 + hk) * NKEY * 64, VW + (size_t)(b * 2 + hk) * NKEY * 64, O + (size_t)row0 * DM + 512 + 64 * h,
                                    4 + (j1 - j0 + 1), j0, 256 * qb, sink[h] * LOG2E, 1.f, lds, tid, lane, wave);
            }
        } else {
            const int v = (u - 4096) & 63; const int b = v >> 3, h = v & 7; const int row0 = NLAT + b * CTXL;
            if (u < 4160) {
                attn_unit<96, false>(QM + (size_t)row0 * 768 + 96 * h, 768, KM + (size_t)(b * 8 + h) * NKEY * 96, VM + (size_t)(b * 8 + h) * NKEY * 64, O + (size_t)row0 * DM + 64 * h,
                                     4, 0, 0, -1e30f, 0.f, lds, tid, lane, wave);
            } else {
                const int hk = h >> 2;
                attn_unit<64, true>(QW + (size_t)row0 * 512 + 64 * h, 512, KW + (size_t)(b * 2 + hk) * NKEY * 64, VW + (size_t)(b * 2 + hk) * NKEY * 64, O + (size_t)row0 * DM + 512 + 64 * h,
                                     4, 0, 0, sink[h] * LOG2E, 1.f, lds, tid, lane, wave);
            }
        }
        __syncthreads();
    }
}
#define MIXER_L1 \
    if (l == 1) { \
        bf16* Z1 = (bf16*)(ws + O_Z1); bf16* OB = (bf16*)(ws + O_OB); \
        PH_BEGIN phase_norm(XL, XC, NTOK, ng + DM, modl, 1, H, lane, gw, NGW); PH_END \
        PROBE_ELT_X(PH_BEGIN phase_norm(XL, XC, NTOK, ng + DM, modl, 1, H, lane, gw, NGW); PH_END) \
        GEMM_PH(pg8::EpiBf16P<1>, H, (const bf16*)(ws + O_IN1), NTOK, ZW1, DM, Z1, ZW1, a.in[33], a.in[35], 0.08838834764831845f) \
        PH_BEGIN gla_scan(Z1, H, OB, lds, tid, lane, wave, G); PH_END \
        PROBE_GLA_X(PH_BEGIN gla_scan(Z1, H, OB, lds, tid, lane, wave, G); PH_END) \
        PH_BEGIN gla_combine(H, OB, Z1, a.in[36], lane, gw, NGW); PH_END \
        GEMM_PH(pg8::EpiResid, H, (const bf16*)(ws + O_OUT1), NLAT, DM, DM, XL, XC, XL, XC, modl + 5 * DM, 1.0f) \
    }
#define MIXER_L0 \
    if (l == 0) { \
        bf16* Z0 = (bf16*)(ws + O_Z0); bf16* CN = (bf16*)(ws + O_CN); bf16* QM = (bf16*)(ws + O_QM); bf16* KM = (bf16*)(ws + O_KM); bf16* VM = (bf16*)(ws + O_VM); \
        bf16* KW = (bf16*)(ws + O_KW); bf16* VW = (bf16*)(ws + O_VW); bf16* QW = (bf16*)(ws + O_QW); \
        PH_BEGIN phase_norm(XL, XC, NTOK, ng + DM, modl, 1, H, lane, gw, NGW); PH_END \
        PROBE_ELT_X(PH_BEGIN phase_norm(XL, XC, NTOK, ng + DM, modl, 1, H, lane, gw, NGW); PH_END) \
        GEMM_PH(pg8::EpiBf16P<0>, H, (const bf16*)(ws + O_IN0), NTOK, ZW0, DM, Z0, ZW0, nullptr, nullptr, 1.0f) \
        PH_BEGIN prep1(a, Z0, CN, KM, KW, VW, QW, lane, gw, NGW); PH_END \
        PROBE_ELT_X(PH_BEGIN prep1(a, Z0, CN, KM, KW, VW, QW, lane, gw, NGW); PH_END) \
        GEMM_PH(pg8::EpiBf16P<0>, CN, (const bf16*)(ws + O_UP), NTOK, UPN, UPK, Z0, UPN, nullptr, nullptr, 1.0f) \
        PH_BEGIN prep2(a, Z0, KM, VM, QM, lane, gw, NGW); PH_END \
        PROBE_ELT_X(PH_BEGIN prep2(a, Z0, KM, VM, QM, lane, gw, NGW); PH_END) \
        PH_BEGIN attn_phase(a, QM, KM, VM, QW, KW, VW, H, lds, tid, lane, wave, G); PH_END \
        PROBE_ATT_X(PH_BEGIN attn_phase(a, QM, KM, VM, QW, KW, VW, H, lds, tid, lane, wave, G); PH_END) \
        GEMM_PH(pg8::EpiResid, H, (const bf16*)(ws + O_OUT0), NTOK, DM, DM, XL, XC, XL, XC, modl + 5 * DM, 1.0f) \
    }
#define MIXER_HOOK MIXER_L0 MIXER_L1


#ifdef PROBE_GU
#define PROBE_GU_X(...) __VA_ARGS__
#else
#define PROBE_GU_X(...)
#endif
#ifdef PROBE_ATT
#define PROBE_ATT_X(...) __VA_ARGS__
#else
#define PROBE_ATT_X(...)
#endif
#ifdef PROBE_GLA
#define PROBE_GLA_X(...) __VA_ARGS__
#else
#define PROBE_GLA_X(...)
#endif
#ifdef PROBE_ELT
#define PROBE_ELT_X(...) __VA_ARGS__
#else
#define PROBE_ELT_X(...)
#endif
#ifdef PROBE_P0
#define PROBE_P0_X(...) __VA_ARGS__
#else
#define PROBE_P0_X(...)
#endif
#define PH_BEGIN { int tid = (int)threadIdx.x; asm volatile("" : "+v"(tid)); const int lane = tid & 63; const int wave = __builtin_amdgcn_readfirstlane(tid >> 6); const int gw = blockIdx.x * NWAVES + wave; (void)lane; (void)gw; (void)wave;
#define PH_END } { XcdBarrier b_; b_.bar = (unsigned*)a.ws; b_.x = xb_xcc_id(); b_.st = (volatile LAS unsigned*)(lds + 131072 + 320) + 8; xcd_barrier(b_); }
#define GEMM_PH(EPI, Aptr, Bptr, Mrows, Ncols, Kdim, ...) PH_BEGIN { int kx_ = (Kdim); asm volatile("" : "+s"(kx_)); pg8::Gemm g{(Aptr), (Bptr), (Mrows), (Ncols), kx_}; pg8::StaticOrder S; S.init((Mrows), (Ncols), G, (int)blockIdx.x); \
    EPI E{__VA_ARGS__}; pg8::gemm_phase<EPI, pg8::StaticOrder, true, true>(lds, g, S, E, tid); } PH_END

__global__ void __launch_bounds__(NTHR, 2) mega(Args a) {
    extern __shared__ __attribute__((aligned(16))) unsigned char lds_[];
    cg::grid_group grid = cg::this_grid();
    LAS unsigned char* lds = (LAS unsigned char*)lds_;
    const int G = gridDim.x, NGW = G * NWAVES;
    unsigned char* ws = a.ws;
    float* XL = a.out; float* XC = (float*)(ws + O_XC);
    bf16* H = (bf16*)(ws + O_H); bf16* HID = (bf16*)(ws + O_HID);
    const float* MOD = (const float*)(ws + O_MOD);

    { volatile LAS unsigned* misc = (volatile LAS unsigned*)(lds + 131072 + 320); if (threadIdx.x < 32) misc[threadIdx.x] = 0u; }
    __syncthreads();
    (void)xcd_barrier_post((unsigned*)ws, (volatile LAS unsigned*)(lds + 131072 + 320) + 8);
    if (gridDim.x == 0x7fffffffu) grid.sync();
    PH_BEGIN phase0(a, lds, tid, lane, wave, G); PH_END
    PROBE_P0_X(PH_BEGIN phase0(a, lds, tid, lane, wave, G); PH_END)
    PH_BEGIN phase_modreduce(a, tid, G); PH_END
#ifdef PROBE_SYNC
    for (int i_ = 0; i_ < 40; ++i_) { PH_BEGIN PH_END }
#endif

#pragma unroll 1
    for (int l = 0; l < 2; ++l) {
        const float* modl = MOD + (size_t)l * 9 * 9216;
        const float* ng = a.in[l == 0 ? 4 : 24];
#pragma unroll 1
        for (int f = 0; f < 2; ++f) {
            const int sub = 2 * f;
            const int nrows = (l == 1 && f == 1) ? NLAT : NTOK;
            const float* xil = (l == 0 && f == 0) ? a.in[0] : XL; const float* xic = (l == 0 && f == 0) ? a.in[2] : XC;
            PH_BEGIN phase_norm(xil, xic, nrows, ng + sub * DM, modl, sub, H, lane, gw, NGW); PH_END
            PROBE_ELT_X(PH_BEGIN phase_norm(xil, xic, nrows, ng + sub * DM, modl, sub, H, lane, gw, NGW); PH_END)
            GEMM_PH(pg8::EpiSwiglu, H, (const bf16*)(ws + (l == 0 ? (f == 0 ? O_GU0A : O_GU0B) : (f == 0 ? O_GU1A : O_GU1B))), nrows, 2 * DFF, DM, HID, DFF)
            PROBE_GU_X(GEMM_PH(pg8::EpiSwiglu, H, (const bf16*)(ws + (l == 0 ? (f == 0 ? O_GU0A : O_GU0B) : (f == 0 ? O_GU1A : O_GU1B))), nrows, 2 * DFF, DM, HID, DFF))
            GEMM_PH(pg8::EpiResid, HID, (const bf16*)(ws + (l == 0 ? (f == 0 ? O_DN0A : O_DN0B) : (f == 0 ? O_DN1A : O_DN1B))), nrows, DM, DFF, xil, xic, XL, XC, modl + (3 * sub + 2) * DM, 0.5f)
            if (f == 0) {
                MIXER_HOOK
            }
        }
    }
}

extern "C" void kernel_launch(void* const* d_in, const int* in_sizes, int n_in, void* d_out, int out_size, void* d_ws, size_t ws_size, hipStream_t stream) {
    static int grid = 0;
    if (grid == 0) {
        int dev = 0, cus = 0, per_cu = 0;
        if (n_in != 38 || ws_size < WS_NEED) { fprintf(stderr, "kernel_launch: n_in %d ws %zu need %zu\n", n_in, ws_size, (size_t)WS_NEED); grid = -1; return; }
        if (hipGetDevice(&dev) != hipSuccess || hipDeviceGetAttribute(&cus, hipDeviceAttributeMultiprocessorCount, dev) != hipSuccess) { grid = -1; return; }
        if (hipFuncSetAttribute((const void*)mega, hipFuncAttributeMaxDynamicSharedMemorySize, LDS_BYTES) != hipSuccess) { fprintf(stderr, "kernel_launch: hipFuncSetAttribute failed\n"); grid = -1; return; }
        if (hipOccupancyMaxActiveBlocksPerMultiprocessor(&per_cu, (const void*)mega, NTHR, LDS_BYTES) != hipSuccess || per_cu < 1) { fprintf(stderr, "kernel_launch: occupancy query %d\n", per_cu); per_cu = 1; (void)hipGetLastError(); }
        grid = cus * per_cu;
    }
    if (grid < 0) return;
    if (hipMemsetAsync(d_ws, 0, 16384, stream) != hipSuccess)     { fprintf(stderr, "kernel_launch: memset failed\n"); return; }
    Args a{};
    for (int i = 0; i < 38; ++i) a.in[i] = (const float*)d_in[i];
    a.out = (float*)d_out; a.ws = (unsigned char*)d_ws;
    void* args[] = {&a};
    hipError_t e = hipLaunchCooperativeKernel((void*)mega, dim3(grid), dim3(NTHR), args, LDS_BYTES, stream);
    if (e != hipSuccess) fprintf(stderr, "cooperative launch failed: %s (grid %d)\n", hipGetErrorString(e), grid);
}
```
